# Optimizing an MI355X kernel written in HIP

```python
import math
import jax, jax.numpy as jnp
from jax import lax
import numpy as np

D_MODEL = 2048
BATCH = 2
SEQ = 8192
DEPTH = 4

CHUNK = 64
Q_BLOCK = 128
D_MIX = D_MODEL
D_ATT = D_MIX // 2
D_SSM = D_MIX - D_ATT
N_HEADS = 8
HEAD_DV = D_ATT // N_HEADS
HEAD_DK = HEAD_DV // 2
SSM_GROUP = 16
N_GROUPS = D_SSM // SSM_GROUP
STATE = 64
N_BUCKETS = 32
MAX_DISTANCE = 128
EPS = 1e-6
NEG_INF = -1e30
D_IN = 4 * D_ATT + 2 * D_SSM

kernel_name = "hybrid_diffattn_s5_parallel_heads"


def lambda_init_fn(layer_idx):
    return 0.8 - 0.6 * math.exp(-0.3 * layer_idx)


def rmsnorm(x, g):
    xf = x.astype(jnp.float32)
    y = xf * lax.rsqrt(jnp.mean(xf * xf, axis=-1, keepdims=True) + EPS)
    return (y * g.astype(jnp.float32)).astype(x.dtype)


def t5_bucket(rel):
    half = N_BUCKETS // 2
    max_exact = half // 2
    n = jnp.abs(rel)
    nf = jnp.maximum(n, 1).astype(jnp.float32)
    large = max_exact + (jnp.log(nf / max_exact) / math.log(MAX_DISTANCE / max_exact)
                         * (half - max_exact)).astype(jnp.int32)
    large = jnp.minimum(large, half - 1)
    return jnp.where(rel > 0, half, 0) + jnp.where(n < max_exact, n, large)


def diff_attention(q, k, v, lam, rel_bias):
    bsz, seq = q.shape[0], q.shape[1]
    scale = HEAD_DK ** -0.5
    k_pos = jnp.arange(seq, dtype=jnp.int32)
    k_chunk = k_pos // CHUNK
    table = rel_bias.astype(jnp.float32)

    def one_block(i):
        start = i * Q_BLOCK
        qb = lax.dynamic_slice_in_dim(q, start, Q_BLOCK, axis=1)
        q_pos = start + jnp.arange(Q_BLOCK, dtype=jnp.int32)
        logits = jnp.einsum("bqhmd,bkhmd->bmhqk", qb, k).astype(jnp.float32) * scale
        bias = jnp.transpose(table[t5_bucket(k_pos[None, :] - q_pos[:, None])], (2, 0, 1))
        allowed = k_chunk[None, :] <= (q_pos // CHUNK)[:, None]
        logits = jnp.where(allowed, logits + bias, NEG_INF)
        p = jax.nn.softmax(logits, axis=-1)
        w = p[:, 0] - lam * p[:, 1]
        return jnp.einsum("bhqk,bkhd->bqhd", w.astype(v.dtype), v)

    out = lax.map(one_block, jnp.arange(seq // Q_BLOCK, dtype=jnp.int32))
    return jnp.transpose(out, (1, 0, 2, 3, 4)).reshape(bsz, seq, N_HEADS, HEAD_DV)


def _diag_linear_combine(e1, e2):
    a1r, a1i, b1r, b1i = e1
    a2r, a2i, b2r, b2i = e2
    ar = a2r * a1r - a2i * a1i
    ai = a2r * a1i + a2i * a1r
    br = a2r * b1r - a2i * b1i + b2r
    bi = a2r * b1i + a2i * b1r + b2i
    return (ar, ai, br, bi)


def s5_ssm(u, a_re, a_im, log_dt, b_re, b_im, c_re, c_im, d_skip):
    f32 = jnp.float32
    bsz, seq = u.shape[0], u.shape[1]
    uf = u.astype(f32)
    ug = uf.reshape(bsz, seq, N_GROUPS, SSM_GROUP)
    a_re = a_re.astype(f32)
    a_im = a_im.astype(f32)
    b_re = b_re.astype(f32)
    b_im = b_im.astype(f32)
    dt = jnp.exp(log_dt.astype(f32))[:, None]
    mag = jnp.exp(dt * a_re)
    ab_re = mag * jnp.cos(dt * a_im)
    ab_im = mag * jnp.sin(dt * a_im)
    den = a_re * a_re + a_im * a_im
    nr = ab_re - 1.0
    cf_re = (nr * a_re + ab_im * a_im) / den
    cf_im = (ab_im * a_re - nr * a_im) / den
    bb_re = cf_re[..., None] * b_re - cf_im[..., None] * b_im
    bb_im = cf_re[..., None] * b_im + cf_im[..., None] * b_re
    bu_re = jnp.einsum("gpc,bsgc->bsgp", bb_re, ug)
    bu_im = jnp.einsum("gpc,bsgc->bsgp", bb_im, ug)
    at_re = jnp.broadcast_to(ab_re, (1, seq, N_GROUPS, STATE))
    at_im = jnp.broadcast_to(ab_im, (1, seq, N_GROUPS, STATE))
    _, _, h_re, h_im = lax.associative_scan(
        _diag_linear_combine, (at_re, at_im, bu_re, bu_im), axis=1)
    y = (jnp.einsum("gcp,bsgp->bsgc", c_re.astype(f32), h_re)
         - jnp.einsum("gcp,bsgp->bsgc", c_im.astype(f32), h_im))
    return y.reshape(bsz, seq, D_SSM) + d_skip.astype(f32) * uf


def setup_inputs(seed: int = 0) -> dict:
    key = jax.random.key(seed)
    ks = jax.random.split(key, 20)
    f32 = jnp.float32
    nrm = lambda k, shape, s: jax.random.normal(k, shape, f32) * s
    x = jax.random.normal(ks[0], (BATCH, SEQ, D_MODEL), f32)
    rel_bias = nrm(ks[1], (N_BUCKETS, N_HEADS), 0.1)
    pre_norm_g = 1.0 + nrm(ks[2], (DEPTH, D_MODEL), 0.02)
    post_norm_g = 1.0 + nrm(ks[3], (DEPTH, D_MODEL), 0.02)
    w_in = nrm(ks[4], (DEPTH, D_MODEL, D_IN), D_MODEL ** -0.5)
    lambda_q1 = nrm(ks[5], (DEPTH, HEAD_DK), 0.1)
    lambda_k1 = nrm(ks[6], (DEPTH, HEAD_DK), 0.1)
    lambda_q2 = nrm(ks[7], (DEPTH, HEAD_DK), 0.1)
    lambda_k2 = nrm(ks[8], (DEPTH, HEAD_DK), 0.1)
    subln_g = 1.0 + nrm(ks[9], (DEPTH, HEAD_DV), 0.02)
    ssm_a_re = -0.5 + nrm(ks[10], (DEPTH, N_GROUPS, STATE), 0.01)
    ssm_a_im = (math.pi * jnp.arange(STATE, dtype=f32))[None, None, :] + nrm(ks[11], (DEPTH, N_GROUPS, STATE), 0.01)
    ssm_log_dt = jax.random.uniform(ks[12], (DEPTH, N_GROUPS), f32, math.log(1e-3), math.log(1e-1))
    ssm_b_re = nrm(ks[13], (DEPTH, N_GROUPS, STATE, SSM_GROUP), (2 * SSM_GROUP) ** -0.5)
    ssm_b_im = nrm(ks[14], (DEPTH, N_GROUPS, STATE, SSM_GROUP), (2 * SSM_GROUP) ** -0.5)
    ssm_c_re = nrm(ks[15], (DEPTH, N_GROUPS, SSM_GROUP, STATE), (2 * STATE) ** -0.5)
    ssm_c_im = nrm(ks[16], (DEPTH, N_GROUPS, SSM_GROUP, STATE), (2 * STATE) ** -0.5)
    ssm_d = nrm(ks[17], (DEPTH, D_SSM), 1.0)
    w_glu = nrm(ks[18], (DEPTH, D_SSM, 2 * D_SSM), D_SSM ** -0.5)
    w_out = nrm(ks[19], (DEPTH, D_MIX, D_MODEL), D_MIX ** -0.5)
    return {"x": x, "rel_bias": rel_bias, "pre_norm_g": pre_norm_g, "post_norm_g": post_norm_g,
            "w_in": w_in, "lambda_q1": lambda_q1, "lambda_k1": lambda_k1,
            "lambda_q2": lambda_q2, "lambda_k2": lambda_k2, "subln_g": subln_g,
            "ssm_a_re": ssm_a_re, "ssm_a_im": ssm_a_im, "ssm_log_dt": ssm_log_dt,
            "ssm_b_re": ssm_b_re, "ssm_b_im": ssm_b_im, "ssm_c_re": ssm_c_re,
            "ssm_c_im": ssm_c_im, "ssm_d": ssm_d, "w_glu": w_glu, "w_out": w_out}


def reference(x, rel_bias, pre_norm_g, post_norm_g, w_in, lambda_q1, lambda_k1,
              lambda_q2, lambda_k2, subln_g, ssm_a_re, ssm_a_im, ssm_log_dt,
              ssm_b_re, ssm_b_im, ssm_c_re, ssm_c_im, ssm_d, w_glu, w_out):
    bsz, seq = x.shape[0], x.shape[1]
    split_at = [D_ATT, 2 * D_ATT, 3 * D_ATT, 4 * D_ATT, 4 * D_ATT + D_SSM]
    for l in range(DEPTH):
        h = rmsnorm(x, pre_norm_g[l])
        proj = jnp.einsum("bsd,de->bse", h, w_in[l])
        q, k, v, z_att, u, z_ssm = jnp.split(proj, split_at, axis=-1)

        lam_init = lambda_init_fn(l)
        lam = (jnp.exp(jnp.sum(lambda_q1[l].astype(jnp.float32) * lambda_k1[l].astype(jnp.float32)))
               - jnp.exp(jnp.sum(lambda_q2[l].astype(jnp.float32) * lambda_k2[l].astype(jnp.float32)))
               + lam_init)
        q = q.reshape(bsz, seq, N_HEADS, 2, HEAD_DK)
        k = k.reshape(bsz, seq, N_HEADS, 2, HEAD_DK)
        v = v.reshape(bsz, seq, N_HEADS, HEAD_DV)
        o_att = diff_attention(q, k, v, lam, rel_bias)
        o_att = rmsnorm(o_att, subln_g[l]) * (1.0 - lam_init)
        o_att = o_att.reshape(bsz, seq, D_ATT) * jax.nn.silu(z_att)

        y = s5_ssm(u, ssm_a_re[l], ssm_a_im[l], ssm_log_dt[l], ssm_b_re[l], ssm_b_im[l],
                   ssm_c_re[l], ssm_c_im[l], ssm_d[l]).astype(x.dtype)
        g = jnp.einsum("bsc,ce->bse", jax.nn.gelu(y), w_glu[l])
        g_val, g_gate = jnp.split(g, 2, axis=-1)
        o_ssm = g_val * jax.nn.sigmoid(g_gate) * jax.nn.silu(z_ssm)

        mix = jnp.einsum("bsc,cd->bsd", jnp.concatenate([o_att, o_ssm], axis=-1), w_out[l])
        x = x + rmsnorm(mix, post_norm_g[l])
    return x
```

```cpp
#include <hip/hip_runtime.h>
#include <hip/hip_cooperative_groups.h>
#include <cstdio>
#include <cstdint>
#include <type_traits>
namespace cg = cooperative_groups;

#define DI __device__ __forceinline__
typedef unsigned short bf16_t;
typedef short bf16x8 __attribute__((ext_vector_type(8)));
typedef short s16x4 __attribute__((ext_vector_type(4)));
typedef float f32x16 __attribute__((ext_vector_type(16)));
typedef float f32x4 __attribute__((ext_vector_type(4)));
typedef float f32x2 __attribute__((ext_vector_type(2)));
typedef __bf16 bf2_t __attribute__((ext_vector_type(2)));
typedef __attribute__((address_space(3))) s16x4 lds_s16x4;
typedef __attribute__((address_space(3))) void lds_void;

constexpr int REP_P1 = 1, REP_P3 = 1, REP_SSM = 1, REP_P56 = 1;
constexpr int SEQ = 8192, NTOK = 16384, DM = 2048, DIN = 6144;
constexpr float LOG2E = 1.4426950408889634f;
constexpr float QSCALE = 0.125f * LOG2E;
constexpr int NTHR = 512;
constexpr int LDS_BYTES = 148752;
constexpr int XBW_OFF = 148736;
constexpr int ATT_STAGE = 32768;
constexpr int ATT_VOFF = 16384;
constexpr int BT_OFF = 147456;

struct Params {
  const float *x, *rel_bias, *pre_g, *post_g, *w_in, *lq1, *lk1, *lq2, *lk2, *subln_g, *a_re, *a_im, *log_dt,
      *b_re, *b_im, *c_re, *c_im, *ssm_d, *w_glu, *w_out;
  float* out;
  bf16_t *wb_in, *wb_glu, *wb_out, *proj, *mixin, *ybuf, *mix, *xb, *xlo, *Kc, *Wst, *Wo, *Hb;
  float *rstd, *lam, *E, *lamL, *zero;
  unsigned* bar;
  unsigned long long use_cg;
};

DI int ltid() { int t = threadIdx.x; asm volatile("" : "+v"(t)); return t; }
DI int crow(int r, int h) { return (r & 3) + 8 * (r >> 2) + 4 * h; }
DI float bf2f(bf16_t u) { return __uint_as_float(((unsigned)u) << 16); }
DI unsigned pk2(float a, float b) { f32x2 v = {a, b}; bf2_t r = __builtin_convertvector(v, bf2_t); return __builtin_bit_cast(unsigned, r); }
DI bf16_t f2bf(float a) { return (bf16_t)(pk2(a, 0.f) & 0xffffu); }
DI float wave_sum(float v) {
#pragma unroll
  for (int o = 32; o >= 1; o >>= 1) v += __shfl_xor(v, o);
  return v;
}
DI float silu_f(float v) { return v * __builtin_amdgcn_rcpf(1.f + __expf(-v)); }
DI float sigmoid_f(float v) { return __builtin_amdgcn_rcpf(1.f + __expf(-v)); }
DI float gelu_tanh_f(float v) { const float u = 1.5957691216057308f * (v + 0.044715f * v * v * v); return v * __builtin_amdgcn_rcpf(1.f + __expf(-u)); }
DI f32x16 mfma32(bf16x8 a, bf16x8 b, f32x16 c) { return __builtin_amdgcn_mfma_f32_32x32x16_bf16(a, b, c, 0, 0, 0); }
DI s16x4 tr_read(const char* p) { return __builtin_amdgcn_ds_read_tr16_b64_v4i16((lds_s16x4*)p); }


#define XB_TMO      128
#define XB_XCNT(j)  (256  + 64 * (j))
#define XB_XSUB(j)  (1280 + 64 * (j))
#define XB_XGEN(j)  (2304 + 64 * (j))
#define XB_TOP      3328
#define XB_TOPGEN   3392
#define XCD_BAR_WORDS 3456
#define XB_SPIN_CAP (1u << 22)
#define LAS __attribute__((address_space(3)))
DI unsigned xb_ld(unsigned* p) { return __hip_atomic_load(p, __ATOMIC_RELAXED, __HIP_MEMORY_SCOPE_AGENT); }
DI unsigned xb_add(unsigned* p, unsigned v) { return __hip_atomic_fetch_add(p, v, __ATOMIC_RELAXED, __HIP_MEMORY_SCOPE_AGENT); }
DI unsigned xb_xcc_id() { return (unsigned)__builtin_amdgcn_s_getreg((3 << 11) | 20) & 0xFu; }
#define XB_SPIN(cond, bar) do { unsigned _sp = 0; while (cond) { __builtin_amdgcn_s_sleep(1); \
    if ((++_sp & 255u) == 0u) { if (xb_ld(&(bar)[XB_TMO])) break; if (_sp > XB_SPIN_CAP) { atomicAdd(&(bar)[XB_TMO], 1u); break; } } } } while (0)
struct XcdBarrier { unsigned* bar; unsigned x; volatile LAS unsigned* st; };
DI XcdBarrier xcd_barrier_post(unsigned* bar, volatile LAS unsigned* st) {
  XcdBarrier b; b.bar = bar; b.x = xb_xcc_id(); b.st = st;
  if (threadIdx.x == 0) (void)xb_add(&bar[XB_XCNT(b.x)], 1u);
  return b;
}
DI void xcd_barrier_complete(unsigned* bar, unsigned x, unsigned& nloc, unsigned& nx) {
  const unsigned G = gridDim.x * gridDim.y * gridDim.z;
  unsigned sum, cnt, mine, sp = 0u;
  for (;;) {
    sum = 0u; cnt = 0u; mine = 0u;
#pragma unroll
    for (unsigned j = 0; j < 16; ++j) { const unsigned c = xb_ld(&bar[XB_XCNT(j)]); sum += c; cnt += (c > 0u) ? 1u : 0u; mine = (j == x) ? c : mine; }
    if (sum == G) break;
    __builtin_amdgcn_s_sleep(1);
    if ((++sp & 255u) == 0u) { if (xb_ld(&bar[XB_TMO])) break; if (sp > XB_SPIN_CAP) { atomicAdd(&bar[XB_TMO], 1u); break; } }
  }
  nloc = mine > 0u ? mine : 1u; nx = cnt > 0u ? cnt : 1u;
}
DI void xcd_barrier(const XcdBarrier& b) {
  asm volatile("s_waitcnt vmcnt(0)" ::: "memory");
  __syncthreads();
  if (threadIdx.x == 0) {
    unsigned* bar = b.bar;
    unsigned bx = b.x; asm volatile("" : "+s"(bx));
    __builtin_amdgcn_s_waitcnt(0);
    unsigned nloc = b.st[0], nx = b.st[1];
    if (nloc == 0u) { xcd_barrier_complete(bar, bx, nloc, nx); b.st[0] = nloc; b.st[1] = nx; }
    const unsigned old = xb_add(&bar[XB_XSUB(bx)], 1u);
    const unsigned gen = old / nloc;
    if (old + 1u == (gen + 1u) * nloc) {
      __builtin_amdgcn_fence(__ATOMIC_RELEASE, "agent");
      asm volatile("s_waitcnt vmcnt(0)" ::: "memory");
      const unsigned og = xb_add(&bar[XB_TOP], 1u);
      const unsigned tg = og / nx;
      if (og + 1u == (tg + 1u) * nx) xb_add(&bar[XB_TOPGEN], 1u);
      else XB_SPIN(xb_ld(&bar[XB_TOPGEN]) == tg, bar);
      __builtin_amdgcn_fence(__ATOMIC_ACQUIRE, "agent");
      xb_add(&bar[XB_XGEN(bx)], 1u);
      asm volatile("s_waitcnt vmcnt(0)" ::: "memory");
    } else {
      XB_SPIN(xb_ld(&bar[XB_XGEN(bx)]) == gen, bar);
      __builtin_amdgcn_fence(__ATOMIC_ACQUIRE, "agent");
      asm volatile("s_waitcnt vmcnt(0)" ::: "memory");
    }
  }
  __syncthreads();
}

template <int WM, int WN, int MT, bool TR, int NSTG, class LA, class LB, class EPI>
DI void gemm_tile(char* lds, const char* gbase, int nk, LA la, LB lb, EPI epi) {
  static_assert(WM * WN == 8, "8 waves");
  static_assert(NSTG == 3 || NSTG == 4, "stages");
  constexpr int BM = WM * 32 * MT, BN = WN * 64, NA = BM / 64, NB = BN / 64, NL = NA + NB, BOFF = BM * 128, STG = BOFF + BN * 128;
  static_assert(NSTG * STG <= 147456, "LDS stage area");
  int tid_ = threadIdx.x; asm volatile("" : "+v"(tid_));
  const int tid = tid_, lane = tid & 63, wave = tid >> 6, wm = wave / WN, wn = wave % WN;
  const int l31 = lane & 31, h = lane >> 5;
  const int lr = lane >> 3, gch = lane & 7;
  f32x16 acc[MT][2];
#pragma unroll
  for (int i = 0; i < MT; ++i)
#pragma unroll
    for (int j = 0; j < 2; ++j)
#pragma unroll
      for (int r = 0; r < 16; ++r) acc[i][j][r] = 0.f;
  const __amdgpu_buffer_rsrc_t rsrc = __builtin_amdgcn_make_buffer_rsrc((void*)gbase, (short)0, 0x7fffffff, 0x00020000);
  auto piece = [&](int kt, int st, int i) {
    char* base = lds + st * STG;
    if (i < NA) {
      const int row = 8 * (wave * NA + i) + lr;
      const int c = gch ^ ((row >> 1) & 7);
      __builtin_amdgcn_raw_ptr_buffer_load_lds(rsrc, (lds_void*)(base + (wave * NA + i) * 1024), 16, la(row, c, kt), 0, 0, 0);
    } else {
      const int i2 = i - NA;
      const int row = 8 * (wave * NB + i2) + lr;
      const int c = gch ^ ((row >> 1) & 7);
      __builtin_amdgcn_raw_ptr_buffer_load_lds(rsrc, (lds_void*)(base + BOFF + (wave * NB + i2) * 1024), 16, lb(row, c, kt), 0, 0, 0);
    }
  };
  const int xs = (l31 >> 1) & 7;
  const int arow = (wm * 32 * MT + l31) * 128, brow = BOFF + (wn * 64 + l31) * 128;
#pragma unroll
  for (int t = 0; t < NSTG - 1; ++t)
    if (t < nk) {
#pragma unroll
      for (int i = 0; i < NL; ++i) piece(t, t, i);
    }
  auto rd = [&](const char* a, int s, bf16x8 (&af)[MT], bf16x8 (&bf)[2]) {
    const int co = 16 * ((2 * s + h) ^ xs);
#pragma unroll
    for (int j = 0; j < 2; ++j) bf[j] = *(const bf16x8*)(a + brow + j * 4096 + co);
#pragma unroll
    for (int i = 0; i < MT; ++i) af[i] = *(const bf16x8*)(a + arow + i * 4096 + co);
  };
  int sc = 0;
#pragma unroll 1
  for (int kt = 0; kt < nk; ++kt) {
    if (NSTG >= 4 && kt + 2 < nk) asm volatile("s_waitcnt vmcnt(%0)" ::"n"(2 * NL) : "memory");
    else if (kt + 1 < nk) asm volatile("s_waitcnt vmcnt(%0)" ::"n"(NL) : "memory");
    else asm volatile("s_waitcnt vmcnt(0)" ::: "memory");
    __builtin_amdgcn_s_barrier();
    asm volatile("" ::: "memory");
    const bool more = (kt + NSTG - 1 < nk);
    const int sf = (sc == 0) ? NSTG - 1 : sc - 1;
    const char* a0 = lds + sc * STG;
    bf16x8 af0[MT], af1[MT], bf0[2], bf1[2];
    rd(a0, 0, af0, bf0);
    rd(a0, 1, af1, bf1);
    __builtin_amdgcn_sched_barrier(0);
#pragma unroll
    for (int s = 0; s < 4; ++s) {
      bf16x8 (&af)[MT] = (s & 1) ? af1 : af0;
      bf16x8 (&bf)[2] = (s & 1) ? bf1 : bf0;
#pragma unroll
      for (int i = 0; i < MT; ++i) {
        acc[i][0] = TR ? mfma32(bf[0], af[i], acc[i][0]) : mfma32(af[i], bf[0], acc[i][0]);
        acc[i][1] = TR ? mfma32(bf[1], af[i], acc[i][1]) : mfma32(af[i], bf[1], acc[i][1]);
        if (s < 2) {
          __builtin_amdgcn_sched_barrier(0);
          const int pi = s * MT + i;
          if (pi < NL) { if (more) piece(kt + NSTG - 1, sf, pi); }
          __builtin_amdgcn_sched_barrier(0);
        }
      }
      if (s == 1) {
#pragma unroll
        for (int pi = 2 * MT; pi < NL; ++pi) { if (more) piece(kt + NSTG - 1, sf, pi); }
      }
      __builtin_amdgcn_sched_barrier(0);
      if (s < 2) { rd(a0, s + 2, af, bf); __builtin_amdgcn_sched_barrier(0); }
    }
    sc = (sc == NSTG - 1) ? 0 : sc + 1;
  }
  epi(acc, wm, wn, l31, h);
  __syncthreads();
}

typedef float f32x4v __attribute__((ext_vector_type(4)));
DI f32x4v mfma16(bf16x8 a, bf16x8 b, f32x4v c) { return __builtin_amdgcn_mfma_f32_16x16x32_bf16(a, b, c, 0, 0, 0); }
template <class LA, class LB, class EPI>
DI void gemm_tile16(char* lds, const char* gbase, int nk, LA la, LB lb, EPI epi) {
  constexpr int STG = 65536, BOFF = 32768, NL = 8;
  int tid_ = threadIdx.x; asm volatile("" : "+v"(tid_));
  const int tid = tid_, lane = tid & 63, wave = tid >> 6, wm = wave >> 2, wn = wave & 3;
  const int l15 = lane & 15, q4 = lane >> 4;
  const int lr = lane >> 3, gch = lane & 7;
  f32x4v acc[8][4];
#pragma unroll
  for (int i = 0; i < 8; ++i)
#pragma unroll
    for (int j = 0; j < 4; ++j)
#pragma unroll
      for (int e = 0; e < 4; ++e) acc[i][j][e] = 0.f;
  const __amdgpu_buffer_rsrc_t rsrc = __builtin_amdgcn_make_buffer_rsrc((void*)gbase, (short)0, 0x7fffffff, 0x00020000);
  auto piece = [&](int kt, int i) {
    char* base = lds + (kt & 1) * STG;
    if (i < 4) {
      const int row = 8 * (wave * 4 + i) + lr;
      const int c = gch ^ ((row >> 1) & 7);
      __builtin_amdgcn_raw_ptr_buffer_load_lds(rsrc, (lds_void*)(base + (wave * 4 + i) * 1024), 16, la(row, c, kt), 0, 0, 0);
    } else {
      const int i2 = i - 4;
      const int row = 8 * (wave * 4 + i2) + lr;
      const int c = gch ^ ((row >> 1) & 7);
      __builtin_amdgcn_raw_ptr_buffer_load_lds(rsrc, (lds_void*)(base + BOFF + (wave * 4 + i2) * 1024), 16, lb(row, c, kt), 0, 0, 0);
    }
  };
  const int xs = (l15 >> 1) & 7;
  const int arow = (wm * 128 + l15) * 128, brow = BOFF + (wn * 64 + l15) * 128;
  const int co0 = 16 * (q4 ^ xs), co1 = 16 * ((4 + q4) ^ xs);
#pragma unroll
  for (int i = 0; i < NL; ++i) piece(0, i);
  auto rdB = [&](const char* a, int co, bf16x8 (&bf)[4]) {
#pragma unroll
    for (int j = 0; j < 4; ++j) bf[j] = *(const bf16x8*)(a + brow + j * 2048 + co);
  };
  auto rdA = [&](const char* a, int co, int half, bf16x8 (&af)[4]) {
#pragma unroll
    for (int i = 0; i < 4; ++i) af[i] = *(const bf16x8*)(a + arow + (half * 4 + i) * 2048 + co);
  };
#pragma unroll 1
  for (int kt = 0; kt < nk; ++kt) {
    asm volatile("s_waitcnt vmcnt(0)" ::: "memory");
    __builtin_amdgcn_s_barrier();
    asm volatile("" ::: "memory");
    const bool more = (kt + 1 < nk);
    const char* a0 = lds + (kt & 1) * STG;
    bf16x8 B0[4], B1[4], Alo[4], Ahi[4];
    rdB(a0, co0, B0);
    rdA(a0, co0, 0, Alo);
    rdA(a0, co0, 1, Ahi);
    __builtin_amdgcn_sched_barrier(0);
#pragma unroll
    for (int i = 0; i < 4; ++i) {
#pragma unroll
      for (int j = 0; j < 4; ++j) acc[i][j] = mfma16(B0[j], Alo[i], acc[i][j]);
      __builtin_amdgcn_sched_barrier(0);
      if (more) piece(kt + 1, i);
      __builtin_amdgcn_sched_barrier(0);
    }
    rdB(a0, co1, B1);
    rdA(a0, co1, 0, Alo);
    __builtin_amdgcn_sched_barrier(0);
#pragma unroll
    for (int i = 0; i < 4; ++i) {
#pragma unroll
      for (int j = 0; j < 4; ++j) acc[4 + i][j] = mfma16(B0[j], Ahi[i], acc[4 + i][j]);
      __builtin_amdgcn_sched_barrier(0);
      if (more) piece(kt + 1, 4 + i);
      __builtin_amdgcn_sched_barrier(0);
    }
    rdA(a0, co1, 1, Ahi);
    __builtin_amdgcn_sched_barrier(0);
#pragma unroll
    for (int i = 0; i < 4; ++i)
#pragma unroll
      for (int j = 0; j < 4; ++j) acc[i][j] = mfma16(B1[j], Alo[i], acc[i][j]);
    __builtin_amdgcn_sched_barrier(0);
#pragma unroll
    for (int i = 0; i < 4; ++i)
#pragma unroll
      for (int j = 0; j < 4; ++j) acc[4 + i][j] = mfma16(B1[j], Ahi[i], acc[4 + i][j]);
  }
  epi(acc, wm, wn, l15, q4);
  __syncthreads();
}

DI void wconv_item(const float* __restrict__ src, int K, int N, bf16_t* __restrict__ dst, const float* __restrict__ gain,
                   int glu_perm, int kt, int ng, char* lds) {
  float* tile = (float*)lds;
  int tid_ = threadIdx.x; asm volatile("" : "+v"(tid_));
  const int tid = tid_;
  __syncthreads();
  f32x4 v[8];
#pragma unroll
  for (int i = 0; i < 8; ++i) {
    const int kk = i * 8 + (tid >> 6), n4 = (tid & 63) * 4;
    const int np = ng * 256 + n4;
    int sc = np;
    if (glu_perm) { const int blk = np >> 6, w = np & 63; const int j = blk * 32 + (w & 31); sc = (w < 32) ? j : 1024 + j; }
    v[i] = __builtin_nontemporal_load((const f32x4*)(src + (size_t)(kt * 64 + kk) * N + sc));
  }
#pragma unroll
  for (int i = 0; i < 8; ++i) {
    const int kk = i * 8 + (tid >> 6), n4 = (tid & 63) * 4;
    if (gain) { const float gg = gain[kt * 64 + kk]; v[i][0] *= gg; v[i][1] *= gg; v[i][2] *= gg; v[i][3] *= gg; }
    *(f32x4*)(tile + kk * 260 + n4) = v[i];
  }
  __syncthreads();
#pragma unroll
  for (int i = 0; i < 4; ++i) {
    const int nn = (tid & 63) + 64 * (i & 3), kc = tid >> 6;
    uint4 w;
    w.x = pk2(tile[(kc * 8 + 0) * 260 + nn], tile[(kc * 8 + 1) * 260 + nn]);
    w.y = pk2(tile[(kc * 8 + 2) * 260 + nn], tile[(kc * 8 + 3) * 260 + nn]);
    w.z = pk2(tile[(kc * 8 + 4) * 260 + nn], tile[(kc * 8 + 5) * 260 + nn]);
    w.w = pk2(tile[(kc * 8 + 6) * 260 + nn], tile[(kc * 8 + 7) * 260 + nn]);
    *(uint4*)(dst + (size_t)(ng * 256 + nn) * K + kt * 64 + kc * 8) = w;
  }
}

DI void xprep_row(const float* __restrict__ x, int row, bf16_t* __restrict__ xb, float* __restrict__ rstd) {
  const int lane = ltid() & 63;
  const float* src = x + (size_t)row * DM;
  float ss = 0.f;
#pragma unroll
  for (int i = 0; i < 4; ++i) {
    const int c = lane * 8 + 512 * i;
    const f32x4 a = __builtin_nontemporal_load((const f32x4*)(src + c)), b = __builtin_nontemporal_load((const f32x4*)(src + c + 4));
    ss += a[0] * a[0] + a[1] * a[1] + a[2] * a[2] + a[3] * a[3] + b[0] * b[0] + b[1] * b[1] + b[2] * b[2] + b[3] * b[3];
    uint4 w; w.x = pk2(a[0], a[1]); w.y = pk2(a[2], a[3]); w.z = pk2(b[0], b[1]); w.w = pk2(b[2], b[3]);
    *(uint4*)(xb + (size_t)row * DM + c) = w;
  }
  ss = wave_sum(ss);
  if (lane == 0) rstd[row] = rsqrtf(ss * (1.f / DM) + 1e-6f);
}

DI void ssm_prep_item(const Params& p, int l, int g, char* lds) {
  float* pwre = (float*)lds;
  float* pwim = pwre + 65 * 65;
  float* Bre = pwim + 65 * 65;
  float* Bim = Bre + 1024;
  float* Cre = Bim + 1024;
  float* Cim = Cre + 1040;
  float* cfre = Cim + 1040;
  float* cfim = cfre + 64;
  int tid_ = threadIdx.x; asm volatile("" : "+v"(tid_));
  const int tid = tid_;
  const int lg = l * 64 + g;
  __syncthreads();
  if (tid < 64) {
    const int pp = tid;
    const double dt = exp((double)p.log_dt[lg]);
    const double ar = p.a_re[lg * 64 + pp], ai = p.a_im[lg * 64 + pp];
    const double mag = exp(dt * ar), lr = mag * cos(dt * ai), li = mag * sin(dt * ai);
    const double den = ar * ar + ai * ai, nr = lr - 1.0;
    cfre[pp] = (float)((nr * ar + li * ai) / den);
    cfim[pp] = (float)((li * ar - nr * ai) / den);
    double wr = 1.0, wi = 0.0;
#pragma unroll 1
    for (int t = 0; t <= 64; ++t) {
      pwre[t * 65 + pp] = (float)wr; pwim[t * 65 + pp] = (float)wi;
      const double n2 = wr * lr - wi * li; wi = wr * li + wi * lr; wr = n2;
    }
    p.lamL[(lg * 64 + pp) * 2] = pwre[64 * 65 + pp];
    p.lamL[(lg * 64 + pp) * 2 + 1] = pwim[64 * 65 + pp];
  }
  for (int e = tid; e < 1024; e += NTHR) { Cre[(e >> 6) * 65 + (e & 63)] = p.c_re[lg * 1024 + e]; Cim[(e >> 6) * 65 + (e & 63)] = p.c_im[lg * 1024 + e]; }
  if (l == 0 && g == 0 && tid < 64) p.zero[tid] = 0.f;
  if (g == 0 && tid == 0) {
    float s1 = 0.f, s2 = 0.f;
    for (int i = 0; i < 64; ++i) { s1 += p.lq1[l * 64 + i] * p.lk1[l * 64 + i]; s2 += p.lq2[l * 64 + i] * p.lk2[l * 64 + i]; }
    const float lam_init = 0.8f - 0.6f * expf(-0.3f * (float)l);
    p.lam[l] = expf(s1) - expf(s2) + lam_init;
  }
  __syncthreads();
  for (int e = tid; e < 1024; e += NTHR) {
    const int pp = e >> 4;
    const float br = p.b_re[lg * 1024 + e], bi = p.b_im[lg * 1024 + e];
    Bre[e] = cfre[pp] * br - cfim[pp] * bi;
    Bim[e] = cfre[pp] * bi + cfim[pp] * br;
  }
  __syncthreads();
#pragma unroll 1
  for (int q = 0; q < 2; ++q) {
    const int idx = tid + NTHR * q, co = idx >> 6, tau = idx & 63;
    float acc[16];
#pragma unroll
    for (int c = 0; c < 16; ++c) acc[c] = 0.f;
#pragma unroll 2
    for (int pp = 0; pp < 64; ++pp) {
      const float cr = Cre[co * 65 + pp], ci = Cim[co * 65 + pp], wr = pwre[tau * 65 + pp], wi = pwim[tau * 65 + pp];
      const float xr = cr * wr - ci * wi, xi = cr * wi + ci * wr;
#pragma unroll
      for (int c = 0; c < 16; ++c) acc[c] += xr * Bre[pp * 16 + c] - xi * Bim[pp * 16 + c];
    }
    uint4 w0, w1;
    w0.x = pk2(acc[0], acc[1]); w0.y = pk2(acc[2], acc[3]); w0.z = pk2(acc[4], acc[5]); w0.w = pk2(acc[6], acc[7]);
    w1.x = pk2(acc[8], acc[9]); w1.y = pk2(acc[10], acc[11]); w1.z = pk2(acc[12], acc[13]); w1.w = pk2(acc[14], acc[15]);
    bf16_t* d = p.Kc + ((size_t)(lg * 16 + co) * 64 + tau) * 16;
    *(uint4*)d = w0; *(uint4*)(d + 8) = w1;
  }
#pragma unroll 1
  for (int q = 0; q < 16; ++q) {
    const int idx = tid + NTHR * q, pr = idx >> 6, s = idx & 63, pp = pr & 63;
    const float wr = pwre[(63 - s) * 65 + pp], wi = pwim[(63 - s) * 65 + pp];
    float v[16];
#pragma unroll
    for (int c = 0; c < 16; ++c) {
      const float br = Bre[pp * 16 + c], bi = Bim[pp * 16 + c];
      v[c] = (pr < 64) ? (wr * br - wi * bi) : (wr * bi + wi * br);
    }
    uint4 w0, w1;
    w0.x = pk2(v[0], v[1]); w0.y = pk2(v[2], v[3]); w0.z = pk2(v[4], v[5]); w0.w = pk2(v[6], v[7]);
    w1.x = pk2(v[8], v[9]); w1.y = pk2(v[10], v[11]); w1.z = pk2(v[12], v[13]); w1.w = pk2(v[14], v[15]);
    bf16_t* d = p.Wst + ((size_t)(lg * 128 + pr)) * 1024 + s * 16;
    *(uint4*)d = w0; *(uint4*)(d + 8) = w1;
  }
#pragma unroll 1
  for (int q = 0; q < 32; ++q) {
    const int idx = tid + NTHR * q, m = idx >> 4, ch = idx & 15, t = m >> 4, co = m & 15;
    float v[8];
#pragma unroll
    for (int j = 0; j < 8; ++j) {
      const int pr = ch * 8 + j, pp = pr & 63;
      const float cr = Cre[co * 65 + pp], ci = Cim[co * 65 + pp], wr = pwre[(t + 1) * 65 + pp], wi = pwim[(t + 1) * 65 + pp];
      v[j] = (pr < 64) ? (cr * wr - ci * wi) : -(cr * wi + ci * wr);
    }
    uint4 w0;
    w0.x = pk2(v[0], v[1]); w0.y = pk2(v[2], v[3]); w0.z = pk2(v[4], v[5]); w0.w = pk2(v[6], v[7]);
    *(uint4*)(p.Wo + ((size_t)(lg * 1024 + m)) * 128 + ch * 8) = w0;
  }
}

typedef unsigned u32x4 __attribute__((ext_vector_type(4)));

DI bf16x8 v_frag(const char* a0, const char* a1) {
  const s16x4 lo = tr_read(a0);
  const s16x4 hi = tr_read(a1);
  return __builtin_shufflevector(lo, hi, 0, 1, 2, 3, 4, 5, 6, 7);
}

template <bool NEAR>
DI void attn_tile(const char* kb, const bf16x8 (&q)[4], f32x16 (&O)[4], float& mrun, float& lsum,
                  const float* btab, int relb, float cfar, int ko0, int ko1, int ko2, int ko3, int vA0, int vA1, bool first, f32x16& I) {
  f32x16 S0, S1;
  auto comp_s = [&]() {
    const bf16x8 k00 = *(const bf16x8*)(kb + ko0), k10 = *(const bf16x8*)(kb + ko0 + 8192);
    const bf16x8 k01 = *(const bf16x8*)(kb + ko1), k11 = *(const bf16x8*)(kb + ko1 + 8192);
    const bf16x8 k02 = *(const bf16x8*)(kb + ko2), k12 = *(const bf16x8*)(kb + ko2 + 8192);
    const bf16x8 k03 = *(const bf16x8*)(kb + ko3), k13 = *(const bf16x8*)(kb + ko3 + 8192);
    __builtin_amdgcn_sched_barrier(0);
    S0 = mfma32(k00, q[0], I); S1 = mfma32(k10, q[0], I);
    S0 = mfma32(k01, q[1], S0); S1 = mfma32(k11, q[1], S1);
    S0 = mfma32(k02, q[2], S0); S1 = mfma32(k12, q[2], S1);
    S0 = mfma32(k03, q[3], S0); S1 = mfma32(k13, q[3], S1);
    if (NEAR) {
#pragma unroll
      for (int r = 0; r < 16; ++r) {
        S0[r] += btab[relb + (r & 3) + 8 * (r >> 2)];
        S1[r] += btab[relb + 32 + (r & 3) + 8 * (r >> 2)];
      }
    }
  };
  comp_s();
  const char* vb = kb + ATT_VOFF;
  bool need = first;
  float ps = 0.f;
  if (!first) {
#pragma unroll
    for (int r = 0; r < 16; ++r) {
      S0[r] = __builtin_amdgcn_exp2f(S0[r]); S1[r] = __builtin_amdgcn_exp2f(S1[r]);
      ps += S0[r];
      ps += S1[r];
    }
    need = __any(!(ps <= 1048576.f));
  }
  if (need) {
    if (!first) comp_s();
    float tmax = fmaxf(S0[0], S1[0]);
#pragma unroll
    for (int r = 1; r < 16; ++r) tmax = fmaxf(tmax, fmaxf(S0[r], S1[r]));
    tmax = fmaxf(tmax, __shfl_xor(tmax, 32));
    const float d = first ? tmax : fmaxf(tmax, 0.f);
    const float alpha = __builtin_amdgcn_exp2f(-d);
#pragma unroll
    for (int dd = 0; dd < 4; ++dd)
#pragma unroll
      for (int r = 0; r < 16; ++r) O[dd][r] *= alpha;
    lsum *= alpha;
    mrun += d;
#pragma unroll
    for (int r = 0; r < 16; ++r) I[r] = cfar - mrun;
    ps = 0.f;
#pragma unroll
    for (int r = 0; r < 16; ++r) {
      S0[r] = __builtin_amdgcn_exp2f(S0[r] - d); S1[r] = __builtin_amdgcn_exp2f(S1[r] - d);
      ps += S0[r];
      ps += S1[r];
    }
  }
  lsum += ps;
  u32x4 u;
  u[0] = pk2(S0[0], S0[1]); u[1] = pk2(S0[2], S0[3]); u[2] = pk2(S0[4], S0[5]); u[3] = pk2(S0[6], S0[7]);
  const bf16x8 p00 = __builtin_bit_cast(bf16x8, u);
  u[0] = pk2(S0[8], S0[9]); u[1] = pk2(S0[10], S0[11]); u[2] = pk2(S0[12], S0[13]); u[3] = pk2(S0[14], S0[15]);
  const bf16x8 p01 = __builtin_bit_cast(bf16x8, u);
  u[0] = pk2(S1[0], S1[1]); u[1] = pk2(S1[2], S1[3]); u[2] = pk2(S1[4], S1[5]); u[3] = pk2(S1[6], S1[7]);
  const bf16x8 p10 = __builtin_bit_cast(bf16x8, u);
  u[0] = pk2(S1[8], S1[9]); u[1] = pk2(S1[10], S1[11]); u[2] = pk2(S1[12], S1[13]); u[3] = pk2(S1[14], S1[15]);
  const bf16x8 p11 = __builtin_bit_cast(bf16x8, u);
#pragma unroll
  for (int d = 0; d < 4; ++d) {
    const int x0 = vA0 ^ (d << 6), x1 = vA1 ^ (d << 6);
    const bf16x8 f0 = v_frag(vb + x0, vb + x1);
    const bf16x8 f1 = v_frag(vb + x0 + 16 * 256, vb + x1 + 16 * 256);
    const bf16x8 f2 = v_frag(vb + x0 + 32 * 256, vb + x1 + 32 * 256);
    const bf16x8 f3 = v_frag(vb + x0 + 48 * 256, vb + x1 + 48 * 256);
    __builtin_amdgcn_sched_barrier(0);
    O[d] = mfma32(f0, p00, O[d]);
    O[d] = mfma32(f1, p01, O[d]);
    O[d] = mfma32(f2, p10, O[d]);
    O[d] = mfma32(f3, p11, O[d]);
  }
}

DI void attn_item(const Params& p, const char* wsb, int l, int item, char* lds) {
  int tid_ = threadIdx.x; asm volatile("" : "+v"(tid_));
  const int tid = tid_, lane = tid & 63, w = tid >> 6, l31 = lane & 31, h = lane >> 5;
  const int rg = w & 3, mp = w >> 2;
  const int b = item >> 8, hd = item & 7, pi = (item >> 3) & 31;
  const __amdgpu_buffer_rsrc_t rsrc = __builtin_amdgcn_make_buffer_rsrc((void*)wsb, (short)0, 0x7fffffff, 0x00020000);
  float* btab = (float*)(lds + BT_OFF);
  const float lam = p.lam[l];
  const float lam_init = 0.8f - 0.6f * __expf(-0.3f * (float)l);
  __syncthreads();
  for (int i = tid; i < 320; i += NTHR) {
    const int rel = i - 255;
    const int n = rel < 0 ? -rel : rel;
    int bk = n < 8 ? n : (n < 12 ? 8 : (n < 16 ? 9 : (n < 23 ? 10 : (n < 32 ? 11 : (n < 46 ? 12 : (n < 64 ? 13 : (n < 91 ? 14 : 15)))))));
    if (rel > 0) bk += 16;
    btab[i] = (p.rel_bias[bk * 8 + hd] - p.rel_bias[15 * 8 + hd]) * LOG2E;
  }
  const float cfar = p.rel_bias[15 * 8 + hd] * LOG2E;
  const size_t rowbase = (size_t)b * SEQ;
  const int swk = ((l31 & 3) << 2) | ((l31 >> 2) & 3);
  const int ko0 = l31 * 256 + 16 * ((mp * 8 + 0 + h) ^ swk), ko1 = l31 * 256 + 16 * ((mp * 8 + 2 + h) ^ swk);
  const int ko2 = l31 * 256 + 16 * ((mp * 8 + 4 + h) ^ swk), ko3 = l31 * 256 + 16 * ((mp * 8 + 6 + h) ^ swk);
  const int q4 = (lane & 15) >> 2, pp = lane & 3, blk = (lane >> 4) & 1;
  const int vA0 = (4 * h + q4) * 256 + 8 * (pp & 1) + 16 * ((blk * 2 + (pp >> 1)) ^ h) + (q4 << 6);
  const int vA1 = (4 * h + 8 + q4) * 256 + 8 * (pp & 1) + 16 * ((blk * 2 + (pp >> 1)) ^ (h + 2)) + (q4 << 6);
  const int srow = 8 * w + (lane >> 4);
  const int lch = lane & 15;

#pragma unroll 1
  for (int half = 0; half < 2; ++half) {
    const int qb = half ? pi : 63 - pi;
    const int q0 = qb * 128, nkt = 2 * qb + 2;
    const int qrow = q0 + 32 * rg + l31;
    const bf16_t* qptr = p.proj + (rowbase + qrow) * DIN + hd * 128 + mp * 64 + h * 8;
    bf16x8 q[4];
#pragma unroll
    for (int s = 0; s < 4; ++s) q[s] = *(const bf16x8*)(qptr + s * 16);
    f32x16 O[4];
#pragma unroll
    for (int d = 0; d < 4; ++d)
#pragma unroll
      for (int r = 0; r < 16; ++r) O[d][r] = 0.f;
    float mrun = 0.f, lsum = 0.f;
    f32x16 I;
#pragma unroll
    for (int r = 0; r < 16; ++r) I[r] = cfar;
    const unsigned kbase = (unsigned)((const char*)(p.proj + rowbase * DIN + 1024 + hd * 128) - wsb);
    auto stage = [&](int kt, int st) {
      char* base = lds + st * ATT_STAGE + w * 2048;
      const unsigned soff = kbase + (unsigned)kt * (64 * DIN * 2);
#pragma unroll
      for (int i = 0; i < 2; ++i) {
        const int row = srow + 4 * i;
        const int c = lch ^ ((((lane >> 4) & 3) << 2) | ((2 * w + i) & 3));
        const unsigned off = (unsigned)((row * DIN + c * 8) * 2);
        __builtin_amdgcn_raw_ptr_buffer_load_lds(rsrc, (lds_void*)(base + i * 1024), 16, off, soff, 0, 0);
        __builtin_amdgcn_raw_ptr_buffer_load_lds(rsrc, (lds_void*)(base + ATT_VOFF + i * 1024), 16, off, soff + 2048u, 0, 0);
      }
    };
    asm volatile("s_waitcnt vmcnt(0)" ::: "memory");
    __syncthreads();
    stage(0, 0);
    asm volatile("s_waitcnt vmcnt(0)" ::: "memory");
    __syncthreads();
    auto step = [&](int kt, auto nearc) {
      constexpr bool NEAR = decltype(nearc)::value;
      if (kt + 1 < nkt) stage(kt + 1, (kt + 1) & 1);
      const char* kb = lds + (kt & 1) * ATT_STAGE;
      const int relb = kt * 64 - qrow + 255 + 4 * h;
      if (kt + 1 < nkt || rg >= 2)
        attn_tile<NEAR>(kb, q, O, mrun, lsum, btab, relb, cfar, ko0, ko1, ko2, ko3, vA0, vA1, kt == 0, I);
      asm volatile("s_waitcnt vmcnt(0)" ::: "memory");
      __syncthreads();
    };
    const int nfar = nkt - 4;
    int kt = 0;
#pragma unroll 1
    for (; kt < nfar; ++kt) step(kt, std::false_type{});
#pragma unroll 1
    for (; kt < nkt; ++kt) step(kt, std::true_type{});
    const float lt = lsum + __shfl_xor(lsum, 32);
    int lane2 = lane; asm volatile("" : "+v"(lane2));
    const int h2 = lane2 >> 5;
    float* xch = (float*)lds + (rg * 64) * 64 + lane2;
    if (mp == 1) {
      const float sc = lam / lt;
#pragma unroll
      for (int d = 0; d < 4; ++d)
#pragma unroll
        for (int r = 0; r < 16; ++r) xch[(d * 16 + r) * 64] = O[d][r] * sc;
    }
    __syncthreads();
    if (mp == 0) {
      const float i0 = 1.f / lt;
      float ssq = 0.f;
#pragma unroll
      for (int d = 0; d < 4; ++d)
#pragma unroll
        for (int r = 0; r < 16; ++r) { const float o = O[d][r] * i0 - xch[(d * 16 + r) * 64]; O[d][r] = o; ssq += o * o; }
      ssq += __shfl_xor(ssq, 32);
      const float rn = rsqrtf(ssq * (1.f / 128.f) + 1e-6f) * (1.f - lam_init);
      const size_t trow = rowbase + q0 + 32 * rg + (lane2 & 31);
      const float* gsp = p.subln_g + l * 128 + 4 * h2;
      const bf16_t* zp = p.proj + trow * DIN + 3072 + hd * 128 + 4 * h2;
      bf16_t* op = p.mixin + trow * DM + hd * 128 + 4 * h2;
#pragma unroll
      for (int d = 0; d < 4; ++d)
#pragma unroll
        for (int g4 = 0; g4 < 4; ++g4) {
          const int dv0 = d * 32 + 8 * g4;
          const f32x4 gs = *(const f32x4*)(gsp + dv0);
          const uint2 z = *(const uint2*)(zp + dv0);
          const float o0 = O[d][4 * g4 + 0] * rn * gs[0] * __uint_as_float(z.x << 16);
          const float o1 = O[d][4 * g4 + 1] * rn * gs[1] * __uint_as_float(z.x & 0xffff0000u);
          const float o2 = O[d][4 * g4 + 2] * rn * gs[2] * __uint_as_float(z.y << 16);
          const float o3 = O[d][4 * g4 + 3] * rn * gs[3] * __uint_as_float(z.y & 0xffff0000u);
          uint2 o; o.x = pk2(o0, o1); o.y = pk2(o2, o3);
          *(uint2*)(op + dv0) = o;
        }
    }
  }
}

DI void resid_row(const Params& p, int l, int row) {
  const int lane = ltid() & 63;
  const bf16_t* mix = p.mix + (size_t)row * DM;
  const float* gp = p.post_g + l * DM;
  float mv[4][8];
  float xv[4][8];
  float ss = 0.f;
#pragma unroll
  for (int i = 0; i < 4; ++i) {
    const int c = lane * 8 + 512 * i;
    const uint4 u = *(const uint4*)(mix + c);
    mv[i][0] = __uint_as_float(u.x << 16); mv[i][1] = __uint_as_float(u.x & 0xffff0000u);
    mv[i][2] = __uint_as_float(u.y << 16); mv[i][3] = __uint_as_float(u.y & 0xffff0000u);
    mv[i][4] = __uint_as_float(u.z << 16); mv[i][5] = __uint_as_float(u.z & 0xffff0000u);
    mv[i][6] = __uint_as_float(u.w << 16); mv[i][7] = __uint_as_float(u.w & 0xffff0000u);
    if (l == 0) {
      const f32x4 xa = __builtin_nontemporal_load((const f32x4*)(p.x + (size_t)row * DM + c)), xc = __builtin_nontemporal_load((const f32x4*)(p.x + (size_t)row * DM + c + 4));
#pragma unroll
      for (int j = 0; j < 4; ++j) { xv[i][j] = xa[j]; xv[i][4 + j] = xc[j]; }
    } else {
      const uint4 hi = *(const uint4*)(p.xb + (size_t)row * DM + c), lo = *(const uint4*)(p.xlo + (size_t)row * DM + c);
      xv[i][0] = __uint_as_float(hi.x << 16) + __uint_as_float(lo.x << 16); xv[i][1] = __uint_as_float(hi.x & 0xffff0000u) + __uint_as_float(lo.x & 0xffff0000u);
      xv[i][2] = __uint_as_float(hi.y << 16) + __uint_as_float(lo.y << 16); xv[i][3] = __uint_as_float(hi.y & 0xffff0000u) + __uint_as_float(lo.y & 0xffff0000u);
      xv[i][4] = __uint_as_float(hi.z << 16) + __uint_as_float(lo.z << 16); xv[i][5] = __uint_as_float(hi.z & 0xffff0000u) + __uint_as_float(lo.z & 0xffff0000u);
      xv[i][6] = __uint_as_float(hi.w << 16) + __uint_as_float(lo.w << 16); xv[i][7] = __uint_as_float(hi.w & 0xffff0000u) + __uint_as_float(lo.w & 0xffff0000u);
    }
#pragma unroll
    for (int j = 0; j < 8; ++j) ss += mv[i][j] * mv[i][j];
  }
  ss = wave_sum(ss);
  const float rs = rsqrtf(ss * (1.f / DM) + 1e-6f);
  float s2 = 0.f;
#pragma unroll
  for (int i = 0; i < 4; ++i) {
    const int c = lane * 8 + 512 * i;
    const f32x4 ga = *(const f32x4*)(gp + c), gb = *(const f32x4*)(gp + c + 4);
    float y[8];
#pragma unroll
    for (int j = 0; j < 4; ++j) { y[j] = xv[i][j] + mv[i][j] * rs * ga[j]; y[4 + j] = xv[i][4 + j] + mv[i][4 + j] * rs * gb[j]; }
    if (l == 3) {
      f32x4 ya = {y[0], y[1], y[2], y[3]}, yb = {y[4], y[5], y[6], y[7]};
      __builtin_nontemporal_store(ya, (f32x4*)(p.out + (size_t)row * DM + c)); __builtin_nontemporal_store(yb, (f32x4*)(p.out + (size_t)row * DM + c + 4));
    } else {
#pragma unroll
      for (int j = 0; j < 8; ++j) s2 += y[j] * y[j];
      uint4 w; w.x = pk2(y[0], y[1]); w.y = pk2(y[2], y[3]); w.z = pk2(y[4], y[5]); w.w = pk2(y[6], y[7]);
      *(uint4*)(p.xb + (size_t)row * DM + c) = w;
      uint4 v;
      v.x = pk2(y[0] - __uint_as_float(w.x << 16), y[1] - __uint_as_float(w.x & 0xffff0000u));
      v.y = pk2(y[2] - __uint_as_float(w.y << 16), y[3] - __uint_as_float(w.y & 0xffff0000u));
      v.z = pk2(y[4] - __uint_as_float(w.z << 16), y[5] - __uint_as_float(w.z & 0xffff0000u));
      v.w = pk2(y[6] - __uint_as_float(w.w << 16), y[7] - __uint_as_float(w.w & 0xffff0000u));
      *(uint4*)(p.xlo + (size_t)row * DM + c) = v;
    }
  }
  if (l != 3) {
    s2 = wave_sum(s2);
    if (lane == 0) p.rstd[row] = rsqrtf(s2 * (1.f / DM) + 1e-6f);
  }
}

__global__ void __launch_bounds__(NTHR, 2) mega(Params p) {
  cg::grid_group grid = cg::this_grid();
  __shared__ __attribute__((aligned(16))) char lds[LDS_BYTES];
  const int G = gridDim.x, bid = blockIdx.x, tid = threadIdx.x;
  const char* wsb = (const char*)p.wb_in;
  if (tid == 0) *(uint4*)(lds + XBW_OFF) = make_uint4(0u, 0u, 0u, 0u);
  __syncthreads();
  const XcdBarrier xb = xcd_barrier_post(p.bar, (volatile LAS unsigned*)(lds + XBW_OFF));
  if (p.use_cg) grid.sync();

  for (int it = bid; it < 256 + 4608 + 2048; it += G) {
    if (it < 256) {
      ssm_prep_item(p, it >> 6, it & 63, lds);
    } else if (it < 256 + 4608) {
      const int j = it - 256, l = j / 1152, r = j % 1152;
      if (r < 768) wconv_item(p.w_in + (size_t)l * DM * DIN, DM, DIN, p.wb_in + (size_t)l * DIN * DM, p.pre_g + l * DM, 0, r / 24, r % 24, lds);
      else if (r < 896) { const int r2 = r - 768; wconv_item(p.w_glu + (size_t)l * 1024 * 2048, 1024, 2048, p.wb_glu + (size_t)l * 2048 * 1024, nullptr, 1, r2 / 8, r2 % 8, lds); }
      else { const int r3 = r - 896; wconv_item(p.w_out + (size_t)l * DM * DM, DM, DM, p.wb_out + (size_t)l * DM * DM, nullptr, 0, r3 / 8, r3 % 8, lds); }
    } else {
      const int row = (it - 256 - 4608) * 8 + (ltid() >> 6);
      xprep_row(p.x, row, p.xb, p.rstd);
    }
  }
  xcd_barrier(xb);

#pragma unroll 1
  for (int l = 0; l < 4; ++l) {
    {
      const bf16_t* A = p.xb;
      const bf16_t* Bt = p.wb_in + (size_t)l * DIN * DM;
      for (int rep = 0; rep < REP_P1; ++rep)
      for (int it = bid; it < 64 * 24; it += G) {
        const int mt = it / 24, nt = it % 24;
        const unsigned a0 = (unsigned)((const char*)(A + (size_t)mt * 256 * DM) - wsb);
        const unsigned b0 = (unsigned)((const char*)(Bt + (size_t)nt * 256 * DM) - wsb);
        auto la = [&](int row, int kc, int kt) { return a0 + (unsigned)((row * DM + kt * 64 + kc * 8) * 2); };
        auto lb = [&](int row, int kc, int kt) { return b0 + (unsigned)((row * DM + kt * 64 + kc * 8) * 2); };
        auto epi = [&](f32x4v (&acc)[8][4], int wm, int wn, int l15, int q4) {
          const int seg = nt >> 2;
          const float qs = (seg == 0) ? QSCALE : 1.f;
          const bool act = (seg == 3 || seg == 5);
#pragma unroll
          for (int i = 0; i < 8; ++i) {
            const int m = mt * 256 + wm * 128 + i * 16 + l15;
            const float rs = p.rstd[m] * qs;
            bf16_t* orow = p.proj + (size_t)m * DIN + nt * 256 + wn * 64 + 4 * q4;
            bf16_t* urow = p.mix + ((size_t)((m >> 13) * 64 + (nt - 16) * 16 + wn * 4) * SEQ + (m & (SEQ - 1))) * 16 + 4 * q4;
#pragma unroll
            for (int j = 0; j < 4; ++j) {
              float v0 = acc[i][j][0] * rs, v1 = acc[i][j][1] * rs, v2 = acc[i][j][2] * rs, v3 = acc[i][j][3] * rs;
              if (act) { v0 = silu_f(v0); v1 = silu_f(v1); v2 = silu_f(v2); v3 = silu_f(v3); }
              uint2 o; o.x = pk2(v0, v1); o.y = pk2(v2, v3);
              if (seg == 4) *(uint2*)(urow + (size_t)j * SEQ * 16) = o;
              else *(uint2*)(orow + j * 16) = o;
            }
          }
        };
        gemm_tile16(lds, wsb, DM / 64, la, lb, epi);
      }
    }
    xcd_barrier(xb);
    for (int rep = 0; rep < REP_P3; ++rep)
    for (int it = bid; it < 128 + 512; it += G) {
      if (it < 128) {
        const int g = 8 * (it & 7) + ((it >> 3) & 7), b = it >> 6, bg = b * 64 + g;
        const unsigned a0 = (unsigned)((const char*)(p.Wst + (size_t)(l * 64 + g) * 128 * 1024) - wsb);
        const unsigned u0 = (unsigned)((const char*)(p.mix + (size_t)bg * SEQ * 16) - wsb);
        auto la = [&](int row, int kc, int kt) { return a0 + (unsigned)((row * 1024 + kt * 64 + kc * 8) * 2); };
        auto lb = [&](int row, int kc, int kt) { return u0 + (unsigned)((row * 1024 + kt * 64 + kc * 8) * 2); };
        float* El = (float*)lds;
        auto epi = [&](f32x16 (&acc)[1][2], int wm, int wn, int l31, int h) {
          __syncthreads();
#pragma unroll
          for (int j = 0; j < 2; ++j)
#pragma unroll
              for (int r = 0; r < 16; ++r) {
                const int m = wm * 32 + crow(r, h), n = wn * 64 + j * 32 + l31;
                El[m * 129 + n] = acc[0][j][r];
              }
        };
        gemm_tile<4, 2, 1, false, 4>(lds, wsb, 16, la, lb, epi);
        __syncthreads();
        const int t2 = ltid();
        if (t2 < 64) {
          const int pp = t2;
          const float lr = p.lamL[((l * 64 + g) * 64 + pp) * 2], li = p.lamL[((l * 64 + g) * 64 + pp) * 2 + 1];
          bf16_t* Hb = p.Hb + (size_t)bg * 128 * 128;
          float hr = 0.f, hi = 0.f;
#pragma unroll 4
          for (int c = 0; c < 128; ++c) {
            Hb[c * 128 + pp] = f2bf(hr);
            Hb[c * 128 + 64 + pp] = f2bf(hi);
            const float er = El[pp * 129 + c], ei = El[(pp + 64) * 129 + c];
            const float n2 = lr * hr - li * hi + er;
            hi = lr * hi + li * hr + ei;
            hr = n2;
          }
        }
        __syncthreads();
      } else {
        attn_item(p, wsb, l, it - 128, lds);
      }
    }
    xcd_barrier(xb);
    for (int rep = 0; rep < REP_SSM; ++rep)
    for (int it = bid; it < 512; it += G) {
      const int jj = it & 255, yy = jj >> 3, g = 8 * (jj & 7) + (yy & 7), b = (yy >> 3) & 1, bg = b * 64 + g;
      const int k4 = ((yy >> 4) & 1) + 2 * (it >> 8), mt = (k4 < 2) ? k4 : 5 - k4;
      const int nkT = 4 * (mt + 1);
      const unsigned kc0 = (unsigned)((const char*)(p.Kc + (size_t)(l * 64 + g) * 16 * 64 * 16) - wsb);
      const unsigned wo0 = (unsigned)((const char*)(p.Wo + (size_t)(l * 64 + g) * 1024 * 128) - wsb);
      const unsigned u0 = (unsigned)((const char*)(p.mix + (size_t)bg * SEQ * 16) - wsb);
      const unsigned hb0 = (unsigned)((const char*)(p.Hb + (size_t)bg * 128 * 128) - wsb);
      const unsigned zero = (unsigned)((const char*)p.zero - wsb);
      auto la = [&](int row, int kc, int kt) -> unsigned {
        const int m = mt * 256 + row, t = m >> 4, co = m & 15;
        if (kt < nkT) {
          const int s = kt * 4 + (kc >> 1);
          return (s <= t) ? kc0 + (unsigned)(((co * 64 + (t - s)) * 16 + (kc & 1) * 8) * 2) : zero;
        }
        return wo0 + (unsigned)((m * 128 + (kt - nkT) * 64 + kc * 8) * 2);
      };
      auto lb = [&](int row, int kc, int kt) -> unsigned {
        if (kt < nkT) return u0 + (unsigned)((row * 1024 + kt * 64 + kc * 8) * 2);
        return hb0 + (unsigned)((row * 128 + (kt - nkT) * 64 + kc * 8) * 2);
      };
      auto epi = [&](f32x16 (&acc)[2][2], int wm, int wn, int l31, int h) {
#pragma unroll
        for (int i = 0; i < 2; ++i)
#pragma unroll
          for (int j = 0; j < 2; ++j) {
            const int c = wn * 64 + j * 32 + l31;
#pragma unroll
            for (int g4 = 0; g4 < 4; ++g4) {
              const int m = mt * 256 + wm * 64 + i * 32 + 8 * g4 + 4 * h;
              const int t = m >> 4, co = m & 15;
              const size_t tok = (size_t)b * SEQ + c * 64 + t;
              const int ch = g * 16 + co;
              const uint2 uu = *(const uint2*)(p.mix + ((size_t)bg * SEQ + c * 64 + t) * 16 + co);
              const f32x4 dd = *(const f32x4*)(p.ssm_d + l * 1024 + ch);
              const float y0 = acc[i][j][4 * g4 + 0] + dd[0] * __uint_as_float(uu.x << 16);
              const float y1 = acc[i][j][4 * g4 + 1] + dd[1] * __uint_as_float(uu.x & 0xffff0000u);
              const float y2 = acc[i][j][4 * g4 + 2] + dd[2] * __uint_as_float(uu.y << 16);
              const float y3 = acc[i][j][4 * g4 + 3] + dd[3] * __uint_as_float(uu.y & 0xffff0000u);
              uint2 o; o.x = pk2(gelu_tanh_f(y0), gelu_tanh_f(y1)); o.y = pk2(gelu_tanh_f(y2), gelu_tanh_f(y3));
              *(uint2*)(p.ybuf + tok * 1024 + ch) = o;
            }
          }
      };
      gemm_tile<4, 2, 2, false, 3>(lds, wsb, nkT + 2, la, lb, epi);
    }
    xcd_barrier(xb);
    {
      const bf16_t* Bt = p.wb_glu + (size_t)l * 2048 * 1024;
      for (int rep = 0; rep < REP_P56; ++rep)
      for (int it = bid; it < 64 * 8; it += G) {
        const int xx = it & 7, yy = (it >> 3) & 31, mt = 32 * (it >> 8) + 8 * (xx >> 1) + (yy & 7), nt = 4 * (xx & 1) + (yy >> 3);
        const unsigned a0 = (unsigned)((const char*)(p.ybuf + (size_t)mt * 256 * 1024) - wsb);
        const unsigned b0 = (unsigned)((const char*)(Bt + (size_t)nt * 256 * 1024) - wsb);
        auto la = [&](int row, int kc, int kt) { return a0 + (unsigned)((row * 1024 + kt * 64 + kc * 8) * 2); };
        auto lb = [&](int row, int kc, int kt) { return b0 + (unsigned)((row * 1024 + kt * 64 + kc * 8) * 2); };
        auto epi = [&](f32x4v (&acc)[8][4], int wm, int wn, int l15, int q4) {
          const int jj = (nt * 4 + wn) * 32 + 4 * q4;
#pragma unroll
          for (int i = 0; i < 8; ++i) {
            const size_t m = (size_t)mt * 256 + wm * 128 + i * 16 + l15;
            const bf16_t* zrow = p.proj + m * DIN + 5120 + jj;
            bf16_t* orow = p.mixin + m * DM + 1024 + jj;
#pragma unroll
            for (int j = 0; j < 2; ++j) {
              const uint2 z = *(const uint2*)(zrow + 16 * j);
              const float v0 = acc[i][j][0] * sigmoid_f(acc[i][j + 2][0]) * __uint_as_float(z.x << 16);
              const float v1 = acc[i][j][1] * sigmoid_f(acc[i][j + 2][1]) * __uint_as_float(z.x & 0xffff0000u);
              const float v2 = acc[i][j][2] * sigmoid_f(acc[i][j + 2][2]) * __uint_as_float(z.y << 16);
              const float v3 = acc[i][j][3] * sigmoid_f(acc[i][j + 2][3]) * __uint_as_float(z.y & 0xffff0000u);
              uint2 o; o.x = pk2(v0, v1); o.y = pk2(v2, v3);
              *(uint2*)(orow + 16 * j) = o;
            }
          }
        };
        gemm_tile16(lds, wsb, 16, la, lb, epi);
      }
    }
    xcd_barrier(xb);
    {
      const bf16_t* Bt = p.wb_out + (size_t)l * DM * DM;
      for (int rep = 0; rep < REP_P56; ++rep)
      for (int it = bid; it < 64 * 8; it += G) {
        const int xx = it & 7, yy = (it >> 3) & 31, mt = 32 * (it >> 8) + 8 * (xx >> 1) + (yy & 7), nt = 4 * (xx & 1) + (yy >> 3);
        const unsigned a0 = (unsigned)((const char*)(p.mixin + (size_t)mt * 256 * DM) - wsb);
        const unsigned b0 = (unsigned)((const char*)(Bt + (size_t)nt * 256 * DM) - wsb);
        auto la = [&](int row, int kc, int kt) { return a0 + (unsigned)((row * DM + kt * 64 + kc * 8) * 2); };
        auto lb = [&](int row, int kc, int kt) { return b0 + (unsigned)((row * DM + kt * 64 + kc * 8) * 2); };
        auto epi = [&](f32x4v (&acc)[8][4], int wm, int wn, int l15, int q4) {
#pragma unroll
          for (int i = 0; i < 8; ++i) {
            const size_t m = (size_t)mt * 256 + wm * 128 + i * 16 + l15;
            bf16_t* orow = p.mix + m * DM + nt * 256 + wn * 64 + 4 * q4;
#pragma unroll
            for (int j = 0; j < 4; ++j) {
              uint2 o; o.x = pk2(acc[i][j][0], acc[i][j][1]); o.y = pk2(acc[i][j][2], acc[i][j][3]);
              *(uint2*)(orow + j * 16) = o;
            }
          }
        };
        gemm_tile16(lds, wsb, DM / 64, la, lb, epi);
      }
    }
    xcd_barrier(xb);
    for (int it = bid; it < NTOK / 8; it += G) resid_row(p, l, it * 8 + (ltid() >> 6));
    xcd_barrier(xb);
  }
}

extern "C" void kernel_launch(void* const* d_in, const int* in_sizes, int n_in, void* d_out, int out_size, void* d_ws,
                              size_t ws_size, hipStream_t stream) {
  static int grid_blocks = 0;
  if (!grid_blocks) {
    int dev = 0, cus = 0, per_cu = 0;
    hipGetDevice(&dev);
    hipDeviceGetAttribute(&cus, hipDeviceAttributeMultiprocessorCount, dev);
    hipOccupancyMaxActiveBlocksPerMultiprocessor(&per_cu, mega, NTHR, 0);
    if (per_cu < 1) per_cu = 1;
    if (per_cu > 1) per_cu = 1;
    grid_blocks = cus * per_cu;
  }
  Params p{};
  p.x = (const float*)d_in[0]; p.rel_bias = (const float*)d_in[1]; p.pre_g = (const float*)d_in[2]; p.post_g = (const float*)d_in[3];
  p.w_in = (const float*)d_in[4]; p.lq1 = (const float*)d_in[5]; p.lk1 = (const float*)d_in[6]; p.lq2 = (const float*)d_in[7];
  p.lk2 = (const float*)d_in[8]; p.subln_g = (const float*)d_in[9]; p.a_re = (const float*)d_in[10]; p.a_im = (const float*)d_in[11];
  p.log_dt = (const float*)d_in[12]; p.b_re = (const float*)d_in[13]; p.b_im = (const float*)d_in[14]; p.c_re = (const float*)d_in[15];
  p.c_im = (const float*)d_in[16]; p.ssm_d = (const float*)d_in[17]; p.w_glu = (const float*)d_in[18]; p.w_out = (const float*)d_in[19];
  p.out = (float*)d_out;
  char* ws = (char*)d_ws;
  size_t off = 0;
  auto take = [&](size_t bytes) { char* r = ws + off; off += (bytes + 255) & ~(size_t)255; return r; };
  p.wb_in = (bf16_t*)take((size_t)4 * DIN * DM * 2);
  p.wb_glu = (bf16_t*)take((size_t)4 * 2048 * 1024 * 2);
  p.wb_out = (bf16_t*)take((size_t)4 * DM * DM * 2);
  p.proj = (bf16_t*)take((size_t)NTOK * DIN * 2);
  p.mixin = (bf16_t*)take((size_t)NTOK * DM * 2);
  p.ybuf = (bf16_t*)take((size_t)NTOK * 1024 * 2);
  p.mix = (bf16_t*)take((size_t)NTOK * DM * 2);
  p.xb = (bf16_t*)take((size_t)NTOK * DM * 2);
  p.Kc = (bf16_t*)take((size_t)4 * 64 * 16 * 64 * 16 * 2);
  p.Wst = (bf16_t*)take((size_t)4 * 64 * 128 * 1024 * 2);
  p.Wo = (bf16_t*)take((size_t)4 * 64 * 1024 * 128 * 2);
  p.Hb = (bf16_t*)take((size_t)128 * 128 * 128 * 2);
  p.rstd = (float*)take((size_t)NTOK * 4);
  p.lam = (float*)take(256);
  p.E = nullptr;
  p.xlo = (bf16_t*)take((size_t)NTOK * DM * 2);
  p.lamL = (float*)take((size_t)4 * 64 * 64 * 2 * 4);
  p.zero = (float*)take(256);
  p.bar = (unsigned*)take(XCD_BAR_WORDS * 4);
  p.use_cg = 0ull;
  if (off > ws_size) { fprintf(stderr, "workspace too small: need %zu have %zu\n", off, ws_size); return; }
  (void)hipMemsetAsync(p.bar, 0, XCD_BAR_WORDS * 4, stream);
  void* args[] = {&p};
  hipError_t e = hipLaunchCooperativeKernel((void*)mega, dim3(grid_blocks), dim3(NTHR), args, 0, stream);
  if (e != hipSuccess) fprintf(stderr, "cooperative launch failed: %s (grid %d)\n", hipGetErrorString(e), grid_blocks);
}
```

```cpp
#include <hip/hip_runtime.h>
#include <hip/hip_cooperative_groups.h>
#include <cstdio>
#include <cstdint>
#include <type_traits>
namespace cg = cooperative_groups;

#define DI __device__ __forceinline__
typedef unsigned short bf16_t;
typedef short bf16x8 __attribute__((ext_vector_type(8)));
typedef short s16x4 __attribute__((ext_vector_type(4)));
typedef float f32x16 __attribute__((ext_vector_type(16)));
typedef float f32x4 __attribute__((ext_vector_type(4)));
typedef float f32x2 __attribute__((ext_vector_type(2)));
typedef __bf16 bf2_t __attribute__((ext_vector_type(2)));
typedef __attribute__((address_space(3))) s16x4 lds_s16x4;
typedef __attribute__((address_space(3))) void lds_void;

constexpr int REP_P1 = 1, REP_P3 = 1, REP_SSM = 1, REP_P56 = 1;
constexpr int SEQ = 8192, NTOK = 16384, DM = 2048, DIN = 6144;
constexpr float LOG2E = 1.4426950408889634f;
constexpr float QSCALE = 0.125f * LOG2E;
constexpr int NTHR = 512;
constexpr int LDS_BYTES = 148752;
constexpr int XBW_OFF = 148736;
constexpr int ATT_STAGE = 32768;
constexpr int ATT_VOFF = 16384;
constexpr int BT_OFF = 147456;

struct Params {
  const float *x, *rel_bias, *pre_g, *post_g, *w_in, *lq1, *lk1, *lq2, *lk2, *subln_g, *a_re, *a_im, *log_dt,
      *b_re, *b_im, *c_re, *c_im, *ssm_d, *w_glu, *w_out;
  float* out;
  bf16_t *wb_in, *wb_glu, *wb_out, *proj, *mixin, *ybuf, *mix, *xb, *xlo, *Kc, *Wst, *Wo, *Hb;
  float *rstd, *lam, *E, *lamL, *zero;
  unsigned* bar;
  unsigned long long use_cg;
};

DI int ltid() { int t = threadIdx.x; asm volatile("" : "+v"(t)); return t; }
DI int crow(int r, int h) { return (r & 3) + 8 * (r >> 2) + 4 * h; }
DI float bf2f(bf16_t u) { return __uint_as_float(((unsigned)u) << 16); }
DI unsigned pk2(float a, float b) { f32x2 v = {a, b}; bf2_t r = __builtin_convertvector(v, bf2_t); return __builtin_bit_cast(unsigned, r); }
DI bf16_t f2bf(float a) { return (bf16_t)(pk2(a, 0.f) & 0xffffu); }
DI float wave_sum(float v) {
#pragma unroll
  for (int o = 32; o >= 1; o >>= 1) v += __shfl_xor(v, o);
  return v;
}
DI float silu_f(float v) { return v * __builtin_amdgcn_rcpf(1.f + __expf(-v)); }
DI float sigmoid_f(float v) { return __builtin_amdgcn_rcpf(1.f + __expf(-v)); }
DI float gelu_tanh_f(float v) { const float u = 1.5957691216057308f * (v + 0.044715f * v * v * v); return v * __builtin_amdgcn_rcpf(1.f + __expf(-u)); }
DI f32x16 mfma32(bf16x8 a, bf16x8 b, f32x16 c) { return __builtin_amdgcn_mfma_f32_32x32x16_bf16(a, b, c, 0, 0, 0); }
DI s16x4 tr_read(const char* p) { return __builtin_amdgcn_ds_read_tr16_b64_v4i16((lds_s16x4*)p); }


#define XB_TMO      128
#define XB_XCNT(j)  (256  + 64 * (j))
#define XB_XSUB(j)  (1280 + 64 * (j))
#define XB_XGEN(j)  (2304 + 64 * (j))
#define XB_TOP      3328
#define XB_TOPGEN   3392
#define XCD_BAR_WORDS 3456
#define XB_SPIN_CAP (1u << 22)
#define LAS __attribute__((address_space(3)))
DI unsigned xb_ld(unsigned* p) { return __hip_atomic_load(p, __ATOMIC_RELAXED, __HIP_MEMORY_SCOPE_AGENT); }
DI unsigned xb_add(unsigned* p, unsigned v) { return __hip_atomic_fetch_add(p, v, __ATOMIC_RELAXED, __HIP_MEMORY_SCOPE_AGENT); }
DI unsigned xb_xcc_id() { return (unsigned)__builtin_amdgcn_s_getreg((3 << 11) | 20) & 0xFu; }
#define XB_SPIN(cond, bar) do { unsigned _sp = 0; while (cond) { __builtin_amdgcn_s_sleep(1); \
    if ((++_sp & 255u) == 0u) { if (xb_ld(&(bar)[XB_TMO])) break; if (_sp > XB_SPIN_CAP) { atomicAdd(&(bar)[XB_TMO], 1u); break; } } } } while (0)
struct XcdBarrier { unsigned* bar; unsigned x; volatile LAS unsigned* st; };
DI XcdBarrier xcd_barrier_post(unsigned* bar, volatile LAS unsigned* st) {
  XcdBarrier b; b.bar = bar; b.x = xb_xcc_id(); b.st = st;
  if (threadIdx.x == 0) (void)xb_add(&bar[XB_XCNT(b.x)], 1u);
  return b;
}
DI void xcd_barrier_complete(unsigned* bar, unsigned x, unsigned& nloc, unsigned& nx) {
  const unsigned G = gridDim.x * gridDim.y * gridDim.z;
  unsigned sum, cnt, mine, sp = 0u;
  for (;;) {
    sum = 0u; cnt = 0u; mine = 0u;
#pragma unroll
    for (unsigned j = 0; j < 16; ++j) { const unsigned c = xb_ld(&bar[XB_XCNT(j)]); sum += c; cnt += (c > 0u) ? 1u : 0u; mine = (j == x) ? c : mine; }
    if (sum == G) break;
    __builtin_amdgcn_s_sleep(1);
    if ((++sp & 255u) == 0u) { if (xb_ld(&bar[XB_TMO])) break; if (sp > XB_SPIN_CAP) { atomicAdd(&bar[XB_TMO], 1u); break; } }
  }
  nloc = mine > 0u ? mine : 1u; nx = cnt > 0u ? cnt : 1u;
}
DI void xcd_barrier(const XcdBarrier& b) {
  asm volatile("s_waitcnt vmcnt(0)" ::: "memory");
  __syncthreads();
  if (threadIdx.x == 0) {
    unsigned* bar = b.bar;
    unsigned bx = b.x; asm volatile("" : "+s"(bx));
    __builtin_amdgcn_s_waitcnt(0);
    unsigned nloc = b.st[0], nx = b.st[1];
    if (nloc == 0u) { xcd_barrier_complete(bar, bx, nloc, nx); b.st[0] = nloc; b.st[1] = nx; }
    const unsigned old = xb_add(&bar[XB_XSUB(bx)], 1u);
    const unsigned gen = old / nloc;
    if (old + 1u == (gen + 1u) * nloc) {
      __builtin_amdgcn_fence(__ATOMIC_RELEASE, "agent");
      asm volatile("s_waitcnt vmcnt(0)" ::: "memory");
      const unsigned og = xb_add(&bar[XB_TOP], 1u);
      const unsigned tg = og / nx;
      if (og + 1u == (tg + 1u) * nx) xb_add(&bar[XB_TOPGEN], 1u);
      else XB_SPIN(xb_ld(&bar[XB_TOPGEN]) == tg, bar);
      __builtin_amdgcn_fence(__ATOMIC_ACQUIRE, "agent");
      xb_add(&bar[XB_XGEN(bx)], 1u);
      asm volatile("s_waitcnt vmcnt(0)" ::: "memory");
    } else {
      XB_SPIN(xb_ld(&bar[XB_XGEN(bx)]) == gen, bar);
      __builtin_amdgcn_fence(__ATOMIC_ACQUIRE, "agent");
      asm volatile("s_waitcnt vmcnt(0)" ::: "memory");
    }
  }
  __syncthreads();
}

template <int WM, int WN, int MT, bool TR, int NSTG, class LA, class LB, class EPI>
DI void gemm_tile(char* lds, const char* gbase, int nk, LA la, LB lb, EPI epi) {
  static_assert(WM * WN == 8, "8 waves");
  static_assert(NSTG == 3 || NSTG == 4, "stages");
  constexpr int BM = WM * 32 * MT, BN = WN * 64, NA = BM / 64, NB = BN / 64, NL = NA + NB, BOFF = BM * 128, STG = BOFF + BN * 128;
  static_assert(NSTG * STG <= 147456, "LDS stage area");
  int tid_ = threadIdx.x; asm volatile("" : "+v"(tid_));
  const int tid = tid_, lane = tid & 63, wave = tid >> 6, wm = wave / WN, wn = wave % WN;
  const int l31 = lane & 31, h = lane >> 5;
  const int lr = lane >> 3, gch = lane & 7;
  f32x16 acc[MT][2];
#pragma unroll
  for (int i = 0; i < MT; ++i)
#pragma unroll
    for (int j = 0; j < 2; ++j)
#pragma unroll
      for (int r = 0; r < 16; ++r) acc[i][j][r] = 0.f;
  const __amdgpu_buffer_rsrc_t rsrc = __builtin_amdgcn_make_buffer_rsrc((void*)gbase, (short)0, 0x7fffffff, 0x00020000);
  auto piece = [&](int kt, int st, int i) {
    char* base = lds + st * STG;
    if (i < NA) {
      const int row = 8 * (wave * NA + i) + lr;
      const int c = gch ^ ((row >> 1) & 7);
      __builtin_amdgcn_raw_ptr_buffer_load_lds(rsrc, (lds_void*)(base + (wave * NA + i) * 1024), 16, la(row, c, kt), 0, 0, 0);
    } else {
      const int i2 = i - NA;
      const int row = 8 * (wave * NB + i2) + lr;
      const int c = gch ^ ((row >> 1) & 7);
      __builtin_amdgcn_raw_ptr_buffer_load_lds(rsrc, (lds_void*)(base + BOFF + (wave * NB + i2) * 1024), 16, lb(row, c, kt), 0, 0, 0);
    }
  };
  const int xs = (l31 >> 1) & 7;
  const int arow = (wm * 32 * MT + l31) * 128, brow = BOFF + (wn * 64 + l31) * 128;
#pragma unroll
  for (int t = 0; t < NSTG - 1; ++t)
    if (t < nk) {
#pragma unroll
      for (int i = 0; i < NL; ++i) piece(t, t, i);
    }
  auto rd = [&](const char* a, int s, bf16x8 (&af)[MT], bf16x8 (&bf)[2]) {
    const int co = 16 * ((2 * s + h) ^ xs);
#pragma unroll
    for (int j = 0; j < 2; ++j) bf[j] = *(const bf16x8*)(a + brow + j * 4096 + co);
#pragma unroll
    for (int i = 0; i < MT; ++i) af[i] = *(const bf16x8*)(a + arow + i * 4096 + co);
  };
  int sc = 0;
#pragma unroll 1
  for (int kt = 0; kt < nk; ++kt) {
    if (NSTG >= 4 && kt + 2 < nk) asm volatile("s_waitcnt vmcnt(%0)" ::"n"(2 * NL) : "memory");
    else if (kt + 1 < nk) asm volatile("s_waitcnt vmcnt(%0)" ::"n"(NL) : "memory");
    else asm volatile("s_waitcnt vmcnt(0)" ::: "memory");
    __builtin_amdgcn_s_barrier();
    asm volatile("" ::: "memory");
    const bool more = (kt + NSTG - 1 < nk);
    const int sf = (sc == 0) ? NSTG - 1 : sc - 1;
    const char* a0 = lds + sc * STG;
    bf16x8 af0[MT], af1[MT], bf0[2], bf1[2];
    rd(a0, 0, af0, bf0);
    rd(a0, 1, af1, bf1);
    __builtin_amdgcn_sched_barrier(0);
#pragma unroll
    for (int s = 0; s < 4; ++s) {
      bf16x8 (&af)[MT] = (s & 1) ? af1 : af0;
      bf16x8 (&bf)[2] = (s & 1) ? bf1 : bf0;
#pragma unroll
      for (int i = 0; i < MT; ++i) {
        acc[i][0] = TR ? mfma32(bf[0], af[i], acc[i][0]) : mfma32(af[i], bf[0], acc[i][0]);
        acc[i][1] = TR ? mfma32(bf[1], af[i], acc[i][1]) : mfma32(af[i], bf[1], acc[i][1]);
        if (s < 2) {
          __builtin_amdgcn_sched_barrier(0);
          const int pi = s * MT + i;
          if (pi < NL) { if (more) piece(kt + NSTG - 1, sf, pi); }
          __builtin_amdgcn_sched_barrier(0);
        }
      }
      if (s == 1) {
#pragma unroll
        for (int pi = 2 * MT; pi < NL; ++pi) { if (more) piece(kt + NSTG - 1, sf, pi); }
      }
      __builtin_amdgcn_sched_barrier(0);
      if (s < 2) { rd(a0, s + 2, af, bf); __builtin_amdgcn_sched_barrier(0); }
    }
    sc = (sc == NSTG - 1) ? 0 : sc + 1;
  }
  epi(acc, wm, wn, l31, h);
  __syncthreads();
}

typedef float f32x4v __attribute__((ext_vector_type(4)));
DI f32x4v mfma16(bf16x8 a, bf16x8 b, f32x4v c) { return __builtin_amdgcn_mfma_f32_16x16x32_bf16(a, b, c, 0, 0, 0); }
template <class LA, class LB, class EPI>
DI void gemm_tile16(char* lds, const char* gbase, int nk, LA la, LB lb, EPI epi) {
  constexpr int STG = 65536, BOFF = 32768, NL = 8;
  int tid_ = threadIdx.x; asm volatile("" : "+v"(tid_));
  const int tid = tid_, lane = tid & 63, wave = tid >> 6, wm = wave >> 2, wn = wave & 3;
  const int l15 = lane & 15, q4 = lane >> 4;
  const int lr = lane >> 3, gch = lane & 7;
  f32x4v acc[8][4];
#pragma unroll
  for (int i = 0; i < 8; ++i)
#pragma unroll
    for (int j = 0; j < 4; ++j)
#pragma unroll
      for (int e = 0; e < 4; ++e) acc[i][j][e] = 0.f;
  const __amdgpu_buffer_rsrc_t rsrc = __builtin_amdgcn_make_buffer_rsrc((void*)gbase, (short)0, 0x7fffffff, 0x00020000);
  auto piece = [&](int kt, int i) {
    char* base = lds + (kt & 1) * STG;
    if (i < 4) {
      const int row = 8 * (wave * 4 + i) + lr;
      const int c = gch ^ ((row >> 1) & 7);
      __builtin_amdgcn_raw_ptr_buffer_load_lds(rsrc, (lds_void*)(base + (wave * 4 + i) * 1024), 16, la(row, c, kt), 0, 0, 0);
    } else {
      const int i2 = i - 4;
      const int row = 8 * (wave * 4 + i2) + lr;
      const int c = gch ^ ((row >> 1) & 7);
      __builtin_amdgcn_raw_ptr_buffer_load_lds(rsrc, (lds_void*)(base + BOFF + (wave * 4 + i2) * 1024), 16, lb(row, c, kt), 0, 0, 0);
    }
  };
  const int xs = (l15 >> 1) & 7;
  const int arow = (wm * 128 + l15) * 128, brow = BOFF + (wn * 64 + l15) * 128;
  const int co0 = 16 * (q4 ^ xs), co1 = 16 * ((4 + q4) ^ xs);
#pragma unroll
  for (int i = 0; i < NL; ++i) piece(0, i);
  auto rdB = [&](const char* a, int co, bf16x8 (&bf)[4]) {
#pragma unroll
    for (int j = 0; j < 4; ++j) bf[j] = *(const bf16x8*)(a + brow + j * 2048 + co);
  };
  auto rdA = [&](const char* a, int co, int half, bf16x8 (&af)[4]) {
#pragma unroll
    for (int i = 0; i < 4; ++i) af[i] = *(const bf16x8*)(a + arow + (half * 4 + i) * 2048 + co);
  };
#pragma unroll 1
  for (int kt = 0; kt < nk; ++kt) {
    asm volatile("s_waitcnt vmcnt(0)" ::: "memory");
    __builtin_amdgcn_s_barrier();
    asm volatile("" ::: "memory");
    const bool more = (kt + 1 < nk);
    const char* a0 = lds + (kt & 1) * STG;
    bf16x8 B0[4], B1[4], Alo[4], Ahi[4];
    Alo[0] = *(const bf16x8*)(a0 + arow + co0);
    rdB(a0, co0, B0);
#pragma unroll
    for (int i = 1; i < 4; ++i) Alo[i] = *(const bf16x8*)(a0 + arow + i * 2048 + co0);
    rdA(a0, co0, 1, Ahi);
    __builtin_amdgcn_sched_barrier(0);
#pragma unroll
    for (int i = 0; i < 4; ++i) {
#pragma unroll
      for (int j = 0; j < 4; ++j) acc[i][j] = mfma16(B0[j], Alo[i], acc[i][j]);
      __builtin_amdgcn_sched_barrier(0);
      if (more) piece(kt + 1, i);
      __builtin_amdgcn_sched_barrier(0);
    }
    rdB(a0, co1, B1);
    rdA(a0, co1, 0, Alo);
    __builtin_amdgcn_sched_barrier(0);
#pragma unroll
    for (int i = 0; i < 4; ++i) {
#pragma unroll
      for (int j = 0; j < 4; ++j) acc[4 + i][j] = mfma16(B0[j], Ahi[i], acc[4 + i][j]);
      __builtin_amdgcn_sched_barrier(0);
      if (more) piece(kt + 1, 4 + i);
      __builtin_amdgcn_sched_barrier(0);
    }
    rdA(a0, co1, 1, Ahi);
    __builtin_amdgcn_sched_barrier(0);
#pragma unroll
    for (int i = 0; i < 4; ++i)
#pragma unroll
      for (int j = 0; j < 4; ++j) acc[i][j] = mfma16(B1[j], Alo[i], acc[i][j]);
    __builtin_amdgcn_sched_barrier(0);
#pragma unroll
    for (int i = 0; i < 4; ++i)
#pragma unroll
      for (int j = 0; j < 4; ++j) acc[4 + i][j] = mfma16(B1[j], Ahi[i], acc[4 + i][j]);
  }
  epi(acc, wm, wn, l15, q4);
  __syncthreads();
}

DI void wconv_item(const float* __restrict__ src, int K, int N, bf16_t* __restrict__ dst, const float* __restrict__ gain,
                   int glu_perm, int kt, int ng, char* lds) {
  float* tile = (float*)lds;
  int tid_ = threadIdx.x; asm volatile("" : "+v"(tid_));
  const int tid = tid_;
  __syncthreads();
  f32x4 v[8];
#pragma unroll
  for (int i = 0; i < 8; ++i) {
    const int kk = i * 8 + (tid >> 6), n4 = (tid & 63) * 4;
    const int np = ng * 256 + n4;
    int sc = np;
    if (glu_perm) { const int blk = np >> 6, w = np & 63; const int j = blk * 32 + (w & 31); sc = (w < 32) ? j : 1024 + j; }
    v[i] = *(const f32x4*)(src + (size_t)(kt * 64 + kk) * N + sc);
  }
#pragma unroll
  for (int i = 0; i < 8; ++i) {
    const int kk = i * 8 + (tid >> 6), n4 = (tid & 63) * 4;
    if (gain) { const float gg = gain[kt * 64 + kk]; v[i][0] *= gg; v[i][1] *= gg; v[i][2] *= gg; v[i][3] *= gg; }
    *(f32x4*)(tile + kk * 260 + n4) = v[i];
  }
  __syncthreads();
#pragma unroll
  for (int i = 0; i < 4; ++i) {
    const int nn = (tid & 63) + 64 * (i & 3), kc = tid >> 6;
    uint4 w;
    w.x = pk2(tile[(kc * 8 + 0) * 260 + nn], tile[(kc * 8 + 1) * 260 + nn]);
    w.y = pk2(tile[(kc * 8 + 2) * 260 + nn], tile[(kc * 8 + 3) * 260 + nn]);
    w.z = pk2(tile[(kc * 8 + 4) * 260 + nn], tile[(kc * 8 + 5) * 260 + nn]);
    w.w = pk2(tile[(kc * 8 + 6) * 260 + nn], tile[(kc * 8 + 7) * 260 + nn]);
    *(uint4*)(dst + (size_t)(ng * 256 + nn) * K + kt * 64 + kc * 8) = w;
  }
}

DI void xprep_row(const float* __restrict__ x, int row, bf16_t* __restrict__ xb, float* __restrict__ rstd) {
  const int lane = ltid() & 63;
  const float* src = x + (size_t)row * DM;
  float ss = 0.f;
#pragma unroll
  for (int i = 0; i < 4; ++i) {
    const int c = lane * 8 + 512 * i;
    const f32x4 a = *(const f32x4*)(src + c), b = *(const f32x4*)(src + c + 4);
    ss += a[0] * a[0] + a[1] * a[1] + a[2] * a[2] + a[3] * a[3] + b[0] * b[0] + b[1] * b[1] + b[2] * b[2] + b[3] * b[3];
    uint4 w; w.x = pk2(a[0], a[1]); w.y = pk2(a[2], a[3]); w.z = pk2(b[0], b[1]); w.w = pk2(b[2], b[3]);
    *(uint4*)(xb + (size_t)row * DM + c) = w;
  }
  ss = wave_sum(ss);
  if (lane == 0) rstd[row] = rsqrtf(ss * (1.f / DM) + 1e-6f);
}

DI void ssm_prep_item(const Params& p, int l, int g, char* lds) {
  float* pwre = (float*)lds;
  float* pwim = pwre + 65 * 65;
  float* Bre = pwim + 65 * 65;
  float* Bim = Bre + 1024;
  float* Cre = Bim + 1024;
  float* Cim = Cre + 1040;
  float* cfre = Cim + 1040;
  float* cfim = cfre + 64;
  int tid_ = threadIdx.x; asm volatile("" : "+v"(tid_));
  const int tid = tid_;
  const int lg = l * 64 + g;
  __syncthreads();
  if (tid < 64) {
    const int pp = tid;
    const double dt = exp((double)p.log_dt[lg]);
    const double ar = p.a_re[lg * 64 + pp], ai = p.a_im[lg * 64 + pp];
    const double mag = exp(dt * ar), lr = mag * cos(dt * ai), li = mag * sin(dt * ai);
    const double den = ar * ar + ai * ai, nr = lr - 1.0;
    cfre[pp] = (float)((nr * ar + li * ai) / den);
    cfim[pp] = (float)((li * ar - nr * ai) / den);
    double wr = 1.0, wi = 0.0;
#pragma unroll 1
    for (int t = 0; t <= 64; ++t) {
      pwre[t * 65 + pp] = (float)wr; pwim[t * 65 + pp] = (float)wi;
      const double n2 = wr * lr - wi * li; wi = wr * li + wi * lr; wr = n2;
    }
    p.lamL[(lg * 64 + pp) * 2] = pwre[64 * 65 + pp];
    p.lamL[(lg * 64 + pp) * 2 + 1] = pwim[64 * 65 + pp];
  }
  for (int e = tid; e < 1024; e += NTHR) { Cre[(e >> 6) * 65 + (e & 63)] = p.c_re[lg * 1024 + e]; Cim[(e >> 6) * 65 + (e & 63)] = p.c_im[lg * 1024 + e]; }
  if (l == 0 && g == 0 && tid < 64) p.zero[tid] = 0.f;
  if (g == 0 && tid == 0) {
    float s1 = 0.f, s2 = 0.f;
    for (int i = 0; i < 64; ++i) { s1 += p.lq1[l * 64 + i] * p.lk1[l * 64 + i]; s2 += p.lq2[l * 64 + i] * p.lk2[l * 64 + i]; }
    const float lam_init = 0.8f - 0.6f * expf(-0.3f * (float)l);
    p.lam[l] = expf(s1) - expf(s2) + lam_init;
  }
  __syncthreads();
  for (int e = tid; e < 1024; e += NTHR) {
    const int pp = e >> 4;
    const float br = p.b_re[lg * 1024 + e], bi = p.b_im[lg * 1024 + e];
    Bre[e] = cfre[pp] * br - cfim[pp] * bi;
    Bim[e] = cfre[pp] * bi + cfim[pp] * br;
  }
  __syncthreads();
#pragma unroll 1
  for (int q = 0; q < 2; ++q) {
    const int idx = tid + NTHR * q, co = idx >> 6, tau = idx & 63;
    float acc[16];
#pragma unroll
    for (int c = 0; c < 16; ++c) acc[c] = 0.f;
#pragma unroll 2
    for (int pp = 0; pp < 64; ++pp) {
      const float cr = Cre[co * 65 + pp], ci = Cim[co * 65 + pp], wr = pwre[tau * 65 + pp], wi = pwim[tau * 65 + pp];
      const float xr = cr * wr - ci * wi, xi = cr * wi + ci * wr;
#pragma unroll
      for (int c = 0; c < 16; ++c) acc[c] += xr * Bre[pp * 16 + c] - xi * Bim[pp * 16 + c];
    }
    uint4 w0, w1;
    w0.x = pk2(acc[0], acc[1]); w0.y = pk2(acc[2], acc[3]); w0.z = pk2(acc[4], acc[5]); w0.w = pk2(acc[6], acc[7]);
    w1.x = pk2(acc[8], acc[9]); w1.y = pk2(acc[10], acc[11]); w1.z = pk2(acc[12], acc[13]); w1.w = pk2(acc[14], acc[15]);
    bf16_t* d = p.Kc + ((size_t)(lg * 16 + co) * 64 + tau) * 16;
    *(uint4*)d = w0; *(uint4*)(d + 8) = w1;
  }
#pragma unroll 1
  for (int q = 0; q < 16; ++q) {
    const int idx = tid + NTHR * q, pr = idx >> 6, s = idx & 63, pp = pr & 63;
    const float wr = pwre[(63 - s) * 65 + pp], wi = pwim[(63 - s) * 65 + pp];
    float v[16];
#pragma unroll
    for (int c = 0; c < 16; ++c) {
      const float br = Bre[pp * 16 + c], bi = Bim[pp * 16 + c];
      v[c] = (pr < 64) ? (wr * br - wi * bi) : (wr * bi + wi * br);
    }
    uint4 w0, w1;
    w0.x = pk2(v[0], v[1]); w0.y = pk2(v[2], v[3]); w0.z = pk2(v[4], v[5]); w0.w = pk2(v[6], v[7]);
    w1.x = pk2(v[8], v[9]); w1.y = pk2(v[10], v[11]); w1.z = pk2(v[12], v[13]); w1.w = pk2(v[14], v[15]);
    bf16_t* d = p.Wst + ((size_t)(lg * 128 + pr)) * 1024 + s * 16;
    *(uint4*)d = w0; *(uint4*)(d + 8) = w1;
  }
#pragma unroll 1
  for (int q = 0; q < 32; ++q) {
    const int idx = tid + NTHR * q, m = idx >> 4, ch = idx & 15, t = m >> 4, co = m & 15;
    float v[8];
#pragma unroll
    for (int j = 0; j < 8; ++j) {
      const int pr = ch * 8 + j, pp = pr & 63;
      const float cr = Cre[co * 65 + pp], ci = Cim[co * 65 + pp], wr = pwre[(t + 1) * 65 + pp], wi = pwim[(t + 1) * 65 + pp];
      v[j] = (pr < 64) ? (cr * wr - ci * wi) : -(cr * wi + ci * wr);
    }
    uint4 w0;
    w0.x = pk2(v[0], v[1]); w0.y = pk2(v[2], v[3]); w0.z = pk2(v[4], v[5]); w0.w = pk2(v[6], v[7]);
    *(uint4*)(p.Wo + ((size_t)(lg * 1024 + m)) * 128 + ch * 8) = w0;
  }
}

typedef unsigned u32x4 __attribute__((ext_vector_type(4)));

DI bf16x8 v_frag(const char* a0, const char* a1) {
  const s16x4 lo = tr_read(a0);
  const s16x4 hi = tr_read(a1);
  return __builtin_shufflevector(lo, hi, 0, 1, 2, 3, 4, 5, 6, 7);
}

template <bool NEAR>
DI void attn_tile(const char* kb, const bf16x8 (&q)[4], f32x16 (&O)[4], float& mrun, float& lsum,
                  const float* btab, int relb, float cfar, int ko0, int ko1, int ko2, int ko3, int vA0, int vA1, bool first, f32x16& I) {
  f32x16 S0, S1;
  auto comp_s = [&]() {
    const bf16x8 k00 = *(const bf16x8*)(kb + ko0), k10 = *(const bf16x8*)(kb + ko0 + 8192);
    const bf16x8 k01 = *(const bf16x8*)(kb + ko1), k11 = *(const bf16x8*)(kb + ko1 + 8192);
    const bf16x8 k02 = *(const bf16x8*)(kb + ko2), k12 = *(const bf16x8*)(kb + ko2 + 8192);
    const bf16x8 k03 = *(const bf16x8*)(kb + ko3), k13 = *(const bf16x8*)(kb + ko3 + 8192);
    __builtin_amdgcn_sched_barrier(0);
    S0 = mfma32(k00, q[0], I); S1 = mfma32(k10, q[0], I);
    S0 = mfma32(k01, q[1], S0); S1 = mfma32(k11, q[1], S1);
    S0 = mfma32(k02, q[2], S0); S1 = mfma32(k12, q[2], S1);
    S0 = mfma32(k03, q[3], S0); S1 = mfma32(k13, q[3], S1);
    if (NEAR) {
#pragma unroll
      for (int r = 0; r < 16; ++r) {
        S0[r] += btab[relb + (r & 3) + 8 * (r >> 2)];
        S1[r] += btab[relb + 32 + (r & 3) + 8 * (r >> 2)];
      }
    }
  };
  comp_s();
  const char* vb = kb + ATT_VOFF;
  bool need = first;
  float ps = 0.f;
  if (!first) {
#pragma unroll
    for (int r = 0; r < 16; ++r) {
      S0[r] = __builtin_amdgcn_exp2f(S0[r]); S1[r] = __builtin_amdgcn_exp2f(S1[r]);
      ps += S0[r];
      ps += S1[r];
    }
    need = __any(!(ps <= 1048576.f));
  }
  if (need) {
    if (!first) comp_s();
    float tmax = fmaxf(S0[0], S1[0]);
#pragma unroll
    for (int r = 1; r < 16; ++r) tmax = fmaxf(tmax, fmaxf(S0[r], S1[r]));
    tmax = fmaxf(tmax, __shfl_xor(tmax, 32));
    const float d = first ? tmax : fmaxf(tmax, 0.f);
    const float alpha = __builtin_amdgcn_exp2f(-d);
#pragma unroll
    for (int dd = 0; dd < 4; ++dd)
#pragma unroll
      for (int r = 0; r < 16; ++r) O[dd][r] *= alpha;
    lsum *= alpha;
    mrun += d;
#pragma unroll
    for (int r = 0; r < 16; ++r) I[r] = cfar - mrun;
    ps = 0.f;
#pragma unroll
    for (int r = 0; r < 16; ++r) {
      S0[r] = __builtin_amdgcn_exp2f(S0[r] - d); S1[r] = __builtin_amdgcn_exp2f(S1[r] - d);
      ps += S0[r];
      ps += S1[r];
    }
  }
  lsum += ps;
  u32x4 u;
  u[0] = pk2(S0[0], S0[1]); u[1] = pk2(S0[2], S0[3]); u[2] = pk2(S0[4], S0[5]); u[3] = pk2(S0[6], S0[7]);
  const bf16x8 p00 = __builtin_bit_cast(bf16x8, u);
  u[0] = pk2(S0[8], S0[9]); u[1] = pk2(S0[10], S0[11]); u[2] = pk2(S0[12], S0[13]); u[3] = pk2(S0[14], S0[15]);
  const bf16x8 p01 = __builtin_bit_cast(bf16x8, u);
  u[0] = pk2(S1[0], S1[1]); u[1] = pk2(S1[2], S1[3]); u[2] = pk2(S1[4], S1[5]); u[3] = pk2(S1[6], S1[7]);
  const bf16x8 p10 = __builtin_bit_cast(bf16x8, u);
  u[0] = pk2(S1[8], S1[9]); u[1] = pk2(S1[10], S1[11]); u[2] = pk2(S1[12], S1[13]); u[3] = pk2(S1[14], S1[15]);
  const bf16x8 p11 = __builtin_bit_cast(bf16x8, u);
#pragma unroll
  for (int d = 0; d < 4; ++d) {
    const int x0 = vA0 ^ (d << 6), x1 = vA1 ^ (d << 6);
    const bf16x8 f0 = v_frag(vb + x0, vb + x1);
    const bf16x8 f1 = v_frag(vb + x0 + 16 * 256, vb + x1 + 16 * 256);
    const bf16x8 f2 = v_frag(vb + x0 + 32 * 256, vb + x1 + 32 * 256);
    const bf16x8 f3 = v_frag(vb + x0 + 48 * 256, vb + x1 + 48 * 256);
    __builtin_amdgcn_sched_barrier(0);
    O[d] = mfma32(f0, p00, O[d]);
    O[d] = mfma32(f1, p01, O[d]);
    O[d] = mfma32(f2, p10, O[d]);
    O[d] = mfma32(f3, p11, O[d]);
  }
}

DI void attn_item(const Params& p, const char* wsb, int l, int item, char* lds) {
  int tid_ = threadIdx.x; asm volatile("" : "+v"(tid_));
  const int tid = tid_, lane = tid & 63, w = tid >> 6, l31 = lane & 31, h = lane >> 5;
  const int rg = w & 3, mp = w >> 2;
  const int b = item >> 8, hd = item & 7, pi = (item >> 3) & 31;
  const __amdgpu_buffer_rsrc_t rsrc = __builtin_amdgcn_make_buffer_rsrc((void*)wsb, (short)0, 0x7fffffff, 0x00020000);
  float* btab = (float*)(lds + BT_OFF);
  const float lam = p.lam[l];
  const float lam_init = 0.8f - 0.6f * __expf(-0.3f * (float)l);
  __syncthreads();
  for (int i = tid; i < 320; i += NTHR) {
    const int rel = i - 255;
    const int n = rel < 0 ? -rel : rel;
    int bk = n < 8 ? n : (n < 12 ? 8 : (n < 16 ? 9 : (n < 23 ? 10 : (n < 32 ? 11 : (n < 46 ? 12 : (n < 64 ? 13 : (n < 91 ? 14 : 15)))))));
    if (rel > 0) bk += 16;
    btab[i] = (p.rel_bias[bk * 8 + hd] - p.rel_bias[15 * 8 + hd]) * LOG2E;
  }
  const float cfar = p.rel_bias[15 * 8 + hd] * LOG2E;
  const size_t rowbase = (size_t)b * SEQ;
  const int swk = ((l31 & 3) << 2) | ((l31 >> 2) & 3);
  const int ko0 = l31 * 256 + 16 * ((mp * 8 + 0 + h) ^ swk), ko1 = l31 * 256 + 16 * ((mp * 8 + 2 + h) ^ swk);
  const int ko2 = l31 * 256 + 16 * ((mp * 8 + 4 + h) ^ swk), ko3 = l31 * 256 + 16 * ((mp * 8 + 6 + h) ^ swk);
  const int q4 = (lane & 15) >> 2, pp = lane & 3, blk = (lane >> 4) & 1;
  const int vA0 = (4 * h + q4) * 256 + 8 * (pp & 1) + 16 * ((blk * 2 + (pp >> 1)) ^ h) + (q4 << 6);
  const int vA1 = (4 * h + 8 + q4) * 256 + 8 * (pp & 1) + 16 * ((blk * 2 + (pp >> 1)) ^ (h + 2)) + (q4 << 6);
  const int srow = 8 * w + (lane >> 4);
  const int lch = lane & 15;

#pragma unroll 1
  for (int half = 0; half < 2; ++half) {
    const int qb = half ? pi : 63 - pi;
    const int q0 = qb * 128, nkt = 2 * qb + 2;
    const int qrow = q0 + 32 * rg + l31;
    const bf16_t* qptr = p.proj + (rowbase + qrow) * DIN + hd * 128 + mp * 64 + h * 8;
    bf16x8 q[4];
#pragma unroll
    for (int s = 0; s < 4; ++s) q[s] = *(const bf16x8*)(qptr + s * 16);
    f32x16 O[4];
#pragma unroll
    for (int d = 0; d < 4; ++d)
#pragma unroll
      for (int r = 0; r < 16; ++r) O[d][r] = 0.f;
    float mrun = 0.f, lsum = 0.f;
    f32x16 I;
#pragma unroll
    for (int r = 0; r < 16; ++r) I[r] = cfar;
    const unsigned kbase = (unsigned)((const char*)(p.proj + rowbase * DIN + 1024 + hd * 128) - wsb);
    auto stage = [&](int kt, int st) {
      char* base = lds + st * ATT_STAGE + w * 2048;
      const unsigned soff = kbase + (unsigned)kt * (64 * DIN * 2);
#pragma unroll
      for (int i = 0; i < 2; ++i) {
        const int row = srow + 4 * i;
        const int c = lch ^ ((((lane >> 4) & 3) << 2) | ((2 * w + i) & 3));
        const unsigned off = (unsigned)((row * DIN + c * 8) * 2);
        __builtin_amdgcn_raw_ptr_buffer_load_lds(rsrc, (lds_void*)(base + i * 1024), 16, off, soff, 0, 0);
        __builtin_amdgcn_raw_ptr_buffer_load_lds(rsrc, (lds_void*)(base + ATT_VOFF + i * 1024), 16, off, soff + 2048u, 0, 0);
      }
    };
    asm volatile("s_waitcnt vmcnt(0)" ::: "memory");
    __syncthreads();
    stage(0, 0);
    asm volatile("s_waitcnt vmcnt(0)" ::: "memory");
    __syncthreads();
    auto step = [&](int kt, auto nearc) {
      constexpr bool NEAR = decltype(nearc)::value;
      if (kt + 1 < nkt) stage(kt + 1, (kt + 1) & 1);
      const char* kb = lds + (kt & 1) * ATT_STAGE;
      const int relb = kt * 64 - qrow + 255 + 4 * h;
      if (kt + 1 < nkt || rg >= 2)
        attn_tile<NEAR>(kb, q, O, mrun, lsum, btab, relb, cfar, ko0, ko1, ko2, ko3, vA0, vA1, kt == 0, I);
      asm volatile("s_waitcnt vmcnt(0)" ::: "memory");
      __syncthreads();
    };
    const int nfar = nkt - 4;
    int kt = 0;
#pragma unroll 1
    for (; kt < nfar; ++kt) step(kt, std::false_type{});
#pragma unroll 1
    for (; kt < nkt; ++kt) step(kt, std::true_type{});
    const float lt = lsum + __shfl_xor(lsum, 32);
    int lane2 = lane; asm volatile("" : "+v"(lane2));
    const int h2 = lane2 >> 5;
    float* xch = (float*)lds + (rg * 64) * 64 + lane2;
    if (mp == 1) {
      const float sc = lam / lt;
#pragma unroll
      for (int d = 0; d < 4; ++d)
#pragma unroll
        for (int r = 0; r < 16; ++r) xch[(d * 16 + r) * 64] = O[d][r] * sc;
    }
    __syncthreads();
    if (mp == 0) {
      const float i0 = 1.f / lt;
      float ssq = 0.f;
#pragma unroll
      for (int d = 0; d < 4; ++d)
#pragma unroll
        for (int r = 0; r < 16; ++r) { const float o = O[d][r] * i0 - xch[(d * 16 + r) * 64]; O[d][r] = o; ssq += o * o; }
      ssq += __shfl_xor(ssq, 32);
      const float rn = rsqrtf(ssq * (1.f / 128.f) + 1e-6f) * (1.f - lam_init);
      const size_t trow = rowbase + q0 + 32 * rg + (lane2 & 31);
      const float* gsp = p.subln_g + l * 128 + 4 * h2;
      const bf16_t* zp = p.proj + trow * DIN + 3072 + hd * 128 + 4 * h2;
      bf16_t* op = p.mixin + trow * DM + hd * 128 + 4 * h2;
#pragma unroll
      for (int d = 0; d < 4; ++d)
#pragma unroll
        for (int g4 = 0; g4 < 4; ++g4) {
          const int dv0 = d * 32 + 8 * g4;
          const f32x4 gs = *(const f32x4*)(gsp + dv0);
          const uint2 z = *(const uint2*)(zp + dv0);
          const float o0 = O[d][4 * g4 + 0] * rn * gs[0] * __uint_as_float(z.x << 16);
          const float o1 = O[d][4 * g4 + 1] * rn * gs[1] * __uint_as_float(z.x & 0xffff0000u);
          const float o2 = O[d][4 * g4 + 2] * rn * gs[2] * __uint_as_float(z.y << 16);
          const float o3 = O[d][4 * g4 + 3] * rn * gs[3] * __uint_as_float(z.y & 0xffff0000u);
          uint2 o; o.x = pk2(o0, o1); o.y = pk2(o2, o3);
          *(uint2*)(op + dv0) = o;
        }
    }
  }
}

DI void resid_row(const Params& p, int l, int row) {
  const int lane = ltid() & 63;
  const bf16_t* mix = p.mix + (size_t)row * DM;
  const float* gp = p.post_g + l * DM;
  float mv[4][8];
  float xv[4][8];
  float ss = 0.f;
#pragma unroll
  for (int i = 0; i < 4; ++i) {
    const int c = lane * 8 + 512 * i;
    const uint4 u = *(const uint4*)(mix + c);
    mv[i][0] = __uint_as_float(u.x << 16); mv[i][1] = __uint_as_float(u.x & 0xffff0000u);
    mv[i][2] = __uint_as_float(u.y << 16); mv[i][3] = __uint_as_float(u.y & 0xffff0000u);
    mv[i][4] = __uint_as_float(u.z << 16); mv[i][5] = __uint_as_float(u.z & 0xffff0000u);
    mv[i][6] = __uint_as_float(u.w << 16); mv[i][7] = __uint_as_float(u.w & 0xffff0000u);
    if (l == 0) {
      const f32x4 xa = *(const f32x4*)(p.x + (size_t)row * DM + c), xc = *(const f32x4*)(p.x + (size_t)row * DM + c + 4);
#pragma unroll
      for (int j = 0; j < 4; ++j) { xv[i][j] = xa[j]; xv[i][4 + j] = xc[j]; }
    } else {
      const uint4 hi = *(const uint4*)(p.xb + (size_t)row * DM + c), lo = *(const uint4*)(p.xlo + (size_t)row * DM + c);
      xv[i][0] = __uint_as_float(hi.x << 16) + __uint_as_float(lo.x << 16); xv[i][1] = __uint_as_float(hi.x & 0xffff0000u) + __uint_as_float(lo.x & 0xffff0000u);
      xv[i][2] = __uint_as_float(hi.y << 16) + __uint_as_float(lo.y << 16); xv[i][3] = __uint_as_float(hi.y & 0xffff0000u) + __uint_as_float(lo.y & 0xffff0000u);
      xv[i][4] = __uint_as_float(hi.z << 16) + __uint_as_float(lo.z << 16); xv[i][5] = __uint_as_float(hi.z & 0xffff0000u) + __uint_as_float(lo.z & 0xffff0000u);
      xv[i][6] = __uint_as_float(hi.w << 16) + __uint_as_float(lo.w << 16); xv[i][7] = __uint_as_float(hi.w & 0xffff0000u) + __uint_as_float(lo.w & 0xffff0000u);
    }
#pragma unroll
    for (int j = 0; j < 8; ++j) ss += mv[i][j] * mv[i][j];
  }
  ss = wave_sum(ss);
  const float rs = rsqrtf(ss * (1.f / DM) + 1e-6f);
  float s2 = 0.f;
#pragma unroll
  for (int i = 0; i < 4; ++i) {
    const int c = lane * 8 + 512 * i;
    const f32x4 ga = *(const f32x4*)(gp + c), gb = *(const f32x4*)(gp + c + 4);
    float y[8];
#pragma unroll
    for (int j = 0; j < 4; ++j) { y[j] = xv[i][j] + mv[i][j] * rs * ga[j]; y[4 + j] = xv[i][4 + j] + mv[i][4 + j] * rs * gb[j]; }
    if (l == 3) {
      f32x4 ya = {y[0], y[1], y[2], y[3]}, yb = {y[4], y[5], y[6], y[7]};
      *(f32x4*)(p.out + (size_t)row * DM + c) = ya; *(f32x4*)(p.out + (size_t)row * DM + c + 4) = yb;
    } else {
#pragma unroll
      for (int j = 0; j < 8; ++j) s2 += y[j] * y[j];
      uint4 w; w.x = pk2(y[0], y[1]); w.y = pk2(y[2], y[3]); w.z = pk2(y[4], y[5]); w.w = pk2(y[6], y[7]);
      *(uint4*)(p.xb + (size_t)row * DM + c) = w;
      uint4 v;
      v.x = pk2(y[0] - __uint_as_float(w.x << 16), y[1] - __uint_as_float(w.x & 0xffff0000u));
      v.y = pk2(y[2] - __uint_as_float(w.y << 16), y[3] - __uint_as_float(w.y & 0xffff0000u));
      v.z = pk2(y[4] - __uint_as_float(w.z << 16), y[5] - __uint_as_float(w.z & 0xffff0000u));
      v.w = pk2(y[6] - __uint_as_float(w.w << 16), y[7] - __uint_as_float(w.w & 0xffff0000u));
      *(uint4*)(p.xlo + (size_t)row * DM + c) = v;
    }
  }
  if (l != 3) {
    s2 = wave_sum(s2);
    if (lane == 0) p.rstd[row] = rsqrtf(s2 * (1.f / DM) + 1e-6f);
  }
}

__global__ void __launch_bounds__(NTHR, 2) mega(Params p) {
  cg::grid_group grid = cg::this_grid();
  __shared__ __attribute__((aligned(16))) char lds[LDS_BYTES];
  const int G = gridDim.x, bid = blockIdx.x, tid = threadIdx.x;
  const char* wsb = (const char*)p.wb_in;
  if (tid == 0) *(uint4*)(lds + XBW_OFF) = make_uint4(0u, 0u, 0u, 0u);
  __syncthreads();
  const XcdBarrier xb = xcd_barrier_post(p.bar, (volatile LAS unsigned*)(lds + XBW_OFF));
  if (p.use_cg) grid.sync();

  for (int it = bid; it < 256 + 4608 + 2048; it += G) {
    if (it < 256) {
      ssm_prep_item(p, it >> 6, it & 63, lds);
    } else if (it < 256 + 4608) {
      const int j = it - 256, l = j / 1152, r = j % 1152;
      if (r < 768) wconv_item(p.w_in + (size_t)l * DM * DIN, DM, DIN, p.wb_in + (size_t)l * DIN * DM, p.pre_g + l * DM, 0, r / 24, r % 24, lds);
      else if (r < 896) { const int r2 = r - 768; wconv_item(p.w_glu + (size_t)l * 1024 * 2048, 1024, 2048, p.wb_glu + (size_t)l * 2048 * 1024, nullptr, 1, r2 / 8, r2 % 8, lds); }
      else { const int r3 = r - 896; wconv_item(p.w_out + (size_t)l * DM * DM, DM, DM, p.wb_out + (size_t)l * DM * DM, nullptr, 0, r3 / 8, r3 % 8, lds); }
    } else {
      const int row = (it - 256 - 4608) * 8 + (ltid() >> 6);
      xprep_row(p.x, row, p.xb, p.rstd);
    }
  }
  xcd_barrier(xb);

#pragma unroll 1
  for (int l = 0; l < 4; ++l) {
    {
      const bf16_t* A = p.xb;
      const bf16_t* Bt = p.wb_in + (size_t)l * DIN * DM;
      for (int rep = 0; rep < REP_P1; ++rep)
      for (int it = bid; it < 64 * 24; it += G) {
        const int mt = it / 24, nt = it % 24;
        const unsigned a0 = (unsigned)((const char*)(A + (size_t)mt * 256 * DM) - wsb);
        const unsigned b0 = (unsigned)((const char*)(Bt + (size_t)nt * 256 * DM) - wsb);
        auto la = [&](int row, int kc, int kt) { return a0 + (unsigned)((row * DM + kt * 64 + kc * 8) * 2); };
        auto lb = [&](int row, int kc, int kt) { return b0 + (unsigned)((row * DM + kt * 64 + kc * 8) * 2); };
        auto epi = [&](f32x4v (&acc)[8][4], int wm, int wn, int l15, int q4) {
          const int seg = nt >> 2;
          const float qs = (seg == 0) ? QSCALE : 1.f;
          const bool act = (seg == 3 || seg == 5);
#pragma unroll
          for (int i = 0; i < 8; ++i) {
            const int m = mt * 256 + wm * 128 + i * 16 + l15;
            const float rs = p.rstd[m] * qs;
            bf16_t* orow = p.proj + (size_t)m * DIN + nt * 256 + wn * 64 + 4 * q4;
            bf16_t* urow = p.mix + ((size_t)((m >> 13) * 64 + (nt - 16) * 16 + wn * 4) * SEQ + (m & (SEQ - 1))) * 16 + 4 * q4;
#pragma unroll
            for (int j = 0; j < 4; ++j) {
              float v0 = acc[i][j][0] * rs, v1 = acc[i][j][1] * rs, v2 = acc[i][j][2] * rs, v3 = acc[i][j][3] * rs;
              if (act) { v0 = silu_f(v0); v1 = silu_f(v1); v2 = silu_f(v2); v3 = silu_f(v3); }
              uint2 o; o.x = pk2(v0, v1); o.y = pk2(v2, v3);
              if (seg == 4) *(uint2*)(urow + (size_t)j * SEQ * 16) = o;
              else *(uint2*)(orow + j * 16) = o;
            }
          }
        };
        gemm_tile16(lds, wsb, DM / 64, la, lb, epi);
      }
    }
    xcd_barrier(xb);
    for (int rep = 0; rep < REP_P3; ++rep)
    for (int it = bid; it < 128 + 512; it += G) {
      if (it < 128) {
        const int g = 8 * (it & 7) + ((it >> 3) & 7), b = it >> 6, bg = b * 64 + g;
        const unsigned a0 = (unsigned)((const char*)(p.Wst + (size_t)(l * 64 + g) * 128 * 1024) - wsb);
        const unsigned u0 = (unsigned)((const char*)(p.mix + (size_t)bg * SEQ * 16) - wsb);
        auto la = [&](int row, int kc, int kt) { return a0 + (unsigned)((row * 1024 + kt * 64 + kc * 8) * 2); };
        auto lb = [&](int row, int kc, int kt) { return u0 + (unsigned)((row * 1024 + kt * 64 + kc * 8) * 2); };
        float* El = (float*)lds;
        auto epi = [&](f32x16 (&acc)[1][2], int wm, int wn, int l31, int h) {
          __syncthreads();
#pragma unroll
          for (int j = 0; j < 2; ++j)
#pragma unroll
              for (int r = 0; r < 16; ++r) {
                const int m = wm * 32 + crow(r, h), n = wn * 64 + j * 32 + l31;
                El[m * 129 + n] = acc[0][j][r];
              }
        };
        gemm_tile<4, 2, 1, false, 4>(lds, wsb, 16, la, lb, epi);
        __syncthreads();
        const int t2 = ltid();
        if (t2 < 64) {
          const int pp = t2;
          const float lr = p.lamL[((l * 64 + g) * 64 + pp) * 2], li = p.lamL[((l * 64 + g) * 64 + pp) * 2 + 1];
          bf16_t* Hb = p.Hb + (size_t)bg * 128 * 128;
          float hr = 0.f, hi = 0.f;
#pragma unroll 4
          for (int c = 0; c < 128; ++c) {
            Hb[c * 128 + pp] = f2bf(hr);
            Hb[c * 128 + 64 + pp] = f2bf(hi);
            const float er = El[pp * 129 + c], ei = El[(pp + 64) * 129 + c];
            const float n2 = lr * hr - li * hi + er;
            hi = lr * hi + li * hr + ei;
            hr = n2;
          }
        }
        __syncthreads();
      } else {
        attn_item(p, wsb, l, it - 128, lds);
      }
    }
    xcd_barrier(xb);
    for (int rep = 0; rep < REP_SSM; ++rep)
    for (int it = bid; it < 512; it += G) {
      const int jj = it & 255, yy = jj >> 3, g = 8 * (jj & 7) + (yy & 7), b = (yy >> 3) & 1, bg = b * 64 + g;
      const int k4 = ((yy >> 4) & 1) + 2 * (it >> 8), mt = (k4 < 2) ? k4 : 5 - k4;
      const int nkT = 4 * (mt + 1);
      const unsigned kc0 = (unsigned)((const char*)(p.Kc + (size_t)(l * 64 + g) * 16 * 64 * 16) - wsb);
      const unsigned wo0 = (unsigned)((const char*)(p.Wo + (size_t)(l * 64 + g) * 1024 * 128) - wsb);
      const unsigned u0 = (unsigned)((const char*)(p.mix + (size_t)bg * SEQ * 16) - wsb);
      const unsigned hb0 = (unsigned)((const char*)(p.Hb + (size_t)bg * 128 * 128) - wsb);
      const unsigned zero = (unsigned)((const char*)p.zero - wsb);
      auto la = [&](int row, int kc, int kt) -> unsigned {
        const int m = mt * 256 + row, t = m >> 4, co = m & 15;
        if (kt < nkT) {
          const int s = kt * 4 + (kc >> 1);
          return (s <= t) ? kc0 + (unsigned)(((co * 64 + (t - s)) * 16 + (kc & 1) * 8) * 2) : zero;
        }
        return wo0 + (unsigned)((m * 128 + (kt - nkT) * 64 + kc * 8) * 2);
      };
      auto lb = [&](int row, int kc, int kt) -> unsigned {
        if (kt < nkT) return u0 + (unsigned)((row * 1024 + kt * 64 + kc * 8) * 2);
        return hb0 + (unsigned)((row * 128 + (kt - nkT) * 64 + kc * 8) * 2);
      };
      auto epi = [&](f32x16 (&acc)[2][2], int wm, int wn, int l31, int h) {
#pragma unroll
        for (int i = 0; i < 2; ++i)
#pragma unroll
          for (int j = 0; j < 2; ++j) {
            const int c = wn * 64 + j * 32 + l31;
#pragma unroll
            for (int g4 = 0; g4 < 4; ++g4) {
              const int m = mt * 256 + wm * 64 + i * 32 + 8 * g4 + 4 * h;
              const int t = m >> 4, co = m & 15;
              const size_t tok = (size_t)b * SEQ + c * 64 + t;
              const int ch = g * 16 + co;
              const uint2 uu = *(const uint2*)(p.mix + ((size_t)bg * SEQ + c * 64 + t) * 16 + co);
              const f32x4 dd = *(const f32x4*)(p.ssm_d + l * 1024 + ch);
              const float y0 = acc[i][j][4 * g4 + 0] + dd[0] * __uint_as_float(uu.x << 16);
              const float y1 = acc[i][j][4 * g4 + 1] + dd[1] * __uint_as_float(uu.x & 0xffff0000u);
              const float y2 = acc[i][j][4 * g4 + 2] + dd[2] * __uint_as_float(uu.y << 16);
              const float y3 = acc[i][j][4 * g4 + 3] + dd[3] * __uint_as_float(uu.y & 0xffff0000u);
              uint2 o; o.x = pk2(gelu_tanh_f(y0), gelu_tanh_f(y1)); o.y = pk2(gelu_tanh_f(y2), gelu_tanh_f(y3));
              *(uint2*)(p.ybuf + tok * 1024 + ch) = o;
            }
          }
      };
      gemm_tile<4, 2, 2, false, 3>(lds, wsb, nkT + 2, la, lb, epi);
    }
    xcd_barrier(xb);
    {
      const bf16_t* Bt = p.wb_glu + (size_t)l * 2048 * 1024;
      for (int rep = 0; rep < REP_P56; ++rep)
      for (int it = bid; it < 64 * 8; it += G) {
        const int xx = it & 7, yy = (it >> 3) & 31, mt = 32 * (it >> 8) + 8 * (xx >> 1) + (yy & 7), nt = 4 * (xx & 1) + (yy >> 3);
        const unsigned a0 = (unsigned)((const char*)(p.ybuf + (size_t)mt * 256 * 1024) - wsb);
        const unsigned b0 = (unsigned)((const char*)(Bt + (size_t)nt * 256 * 1024) - wsb);
        auto la = [&](int row, int kc, int kt) { return a0 + (unsigned)((row * 1024 + kt * 64 + kc * 8) * 2); };
        auto lb = [&](int row, int kc, int kt) { return b0 + (unsigned)((row * 1024 + kt * 64 + kc * 8) * 2); };
        auto epi = [&](f32x4v (&acc)[8][4], int wm, int wn, int l15, int q4) {
          const int jj = (nt * 4 + wn) * 32 + 4 * q4;
#pragma unroll
          for (int i = 0; i < 8; ++i) {
            const size_t m = (size_t)mt * 256 + wm * 128 + i * 16 + l15;
            const bf16_t* zrow = p.proj + m * DIN + 5120 + jj;
            bf16_t* orow = p.mixin + m * DM + 1024 + jj;
#pragma unroll
            for (int j = 0; j < 2; ++j) {
              const uint2 z = *(const uint2*)(zrow + 16 * j);
              const float v0 = acc[i][j][0] * sigmoid_f(acc[i][j + 2][0]) * __uint_as_float(z.x << 16);
              const float v1 = acc[i][j][1] * sigmoid_f(acc[i][j + 2][1]) * __uint_as_float(z.x & 0xffff0000u);
              const float v2 = acc[i][j][2] * sigmoid_f(acc[i][j + 2][2]) * __uint_as_float(z.y << 16);
              const float v3 = acc[i][j][3] * sigmoid_f(acc[i][j + 2][3]) * __uint_as_float(z.y & 0xffff0000u);
              uint2 o; o.x = pk2(v0, v1); o.y = pk2(v2, v3);
              *(uint2*)(orow + 16 * j) = o;
            }
          }
        };
        gemm_tile16(lds, wsb, 16, la, lb, epi);
      }
    }
    xcd_barrier(xb);
    {
      const bf16_t* Bt = p.wb_out + (size_t)l * DM * DM;
      for (int rep = 0; rep < REP_P56; ++rep)
      for (int it = bid; it < 64 * 8; it += G) {
        const int xx = it & 7, yy = (it >> 3) & 31, mt = 32 * (it >> 8) + 8 * (xx >> 1) + (yy & 7), nt = 4 * (xx & 1) + (yy >> 3);
        const unsigned a0 = (unsigned)((const char*)(p.mixin + (size_t)mt * 256 * DM) - wsb);
        const unsigned b0 = (unsigned)((const char*)(Bt + (size_t)nt * 256 * DM) - wsb);
        auto la = [&](int row, int kc, int kt) { return a0 + (unsigned)((row * DM + kt * 64 + kc * 8) * 2); };
        auto lb = [&](int row, int kc, int kt) { return b0 + (unsigned)((row * DM + kt * 64 + kc * 8) * 2); };
        auto epi = [&](f32x4v (&acc)[8][4], int wm, int wn, int l15, int q4) {
#pragma unroll
          for (int i = 0; i < 8; ++i) {
            const size_t m = (size_t)mt * 256 + wm * 128 + i * 16 + l15;
            bf16_t* orow = p.mix + m * DM + nt * 256 + wn * 64 + 4 * q4;
#pragma unroll
            for (int j = 0; j < 4; ++j) {
              uint2 o; o.x = pk2(acc[i][j][0], acc[i][j][1]); o.y = pk2(acc[i][j][2], acc[i][j][3]);
              *(uint2*)(orow + j * 16) = o;
            }
          }
        };
        gemm_tile16(lds, wsb, DM / 64, la, lb, epi);
      }
    }
    xcd_barrier(xb);
    for (int it = bid; it < NTOK / 8; it += G) resid_row(p, l, it * 8 + (ltid() >> 6));
    xcd_barrier(xb);
  }
}

extern "C" void kernel_launch(void* const* d_in, const int* in_sizes, int n_in, void* d_out, int out_size, void* d_ws,
                              size_t ws_size, hipStream_t stream) {
  static int grid_blocks = 0;
  if (!grid_blocks) {
    int dev = 0, cus = 0, per_cu = 0;
    hipGetDevice(&dev);
    hipDeviceGetAttribute(&cus, hipDeviceAttributeMultiprocessorCount, dev);
    hipOccupancyMaxActiveBlocksPerMultiprocessor(&per_cu, mega, NTHR, 0);
    if (per_cu < 1) per_cu = 1;
    if (per_cu > 1) per_cu = 1;
    grid_blocks = cus * per_cu;
  }
  Params p{};
  p.x = (const float*)d_in[0]; p.rel_bias = (const float*)d_in[1]; p.pre_g = (const float*)d_in[2]; p.post_g = (const float*)d_in[3];
  p.w_in = (const float*)d_in[4]; p.lq1 = (const float*)d_in[5]; p.lk1 = (const float*)d_in[6]; p.lq2 = (const float*)d_in[7];
  p.lk2 = (const float*)d_in[8]; p.subln_g = (const float*)d_in[9]; p.a_re = (const float*)d_in[10]; p.a_im = (const float*)d_in[11];
  p.log_dt = (const float*)d_in[12]; p.b_re = (const float*)d_in[13]; p.b_im = (const float*)d_in[14]; p.c_re = (const float*)d_in[15];
  p.c_im = (const float*)d_in[16]; p.ssm_d = (const float*)d_in[17]; p.w_glu = (const float*)d_in[18]; p.w_out = (const float*)d_in[19];
  p.out = (float*)d_out;
  char* ws = (char*)d_ws;
  size_t off = 0;
  auto take = [&](size_t bytes) { char* r = ws + off; off += (bytes + 255) & ~(size_t)255; return r; };
  p.wb_in = (bf16_t*)take((size_t)4 * DIN * DM * 2);
  p.wb_glu = (bf16_t*)take((size_t)4 * 2048 * 1024 * 2);
  p.wb_out = (bf16_t*)take((size_t)4 * DM * DM * 2);
  p.proj = (bf16_t*)take((size_t)NTOK * DIN * 2);
  p.mixin = (bf16_t*)take((size_t)NTOK * DM * 2);
  p.ybuf = (bf16_t*)take((size_t)NTOK * 1024 * 2);
  p.mix = (bf16_t*)take((size_t)NTOK * DM * 2);
  p.xb = (bf16_t*)take((size_t)NTOK * DM * 2);
  p.Kc = (bf16_t*)take((size_t)4 * 64 * 16 * 64 * 16 * 2);
  p.Wst = (bf16_t*)take((size_t)4 * 64 * 128 * 1024 * 2);
  p.Wo = (bf16_t*)take((size_t)4 * 64 * 1024 * 128 * 2);
  p.Hb = (bf16_t*)take((size_t)128 * 128 * 128 * 2);
  p.rstd = (float*)take((size_t)NTOK * 4);
  p.lam = (float*)take(256);
  p.E = nullptr;
  p.xlo = (bf16_t*)take((size_t)NTOK * DM * 2);
  p.lamL = (float*)take((size_t)4 * 64 * 64 * 2 * 4);
  p.zero = (float*)take(256);
  p.bar = (unsigned*)take(XCD_BAR_WORDS * 4);
  p.use_cg = 0ull;
  if (off > ws_size) { fprintf(stderr, "workspace too small: need %zu have %zu\n", off, ws_size); return; }
  (void)hipMemsetAsync(p.bar, 0, XCD_BAR_WORDS * 4, stream);
  void* args[] = {&p};
  hipError_t e = hipLaunchCooperativeKernel((void*)mega, dim3(grid_blocks), dim3(NTHR), args, 0, stream);
  if (e != hipSuccess) fprintf(stderr, "cooperative launch failed: %s (grid %d)\n", hipGetErrorString(e), grid_blocks);
}
```

```cpp
#include <hip/hip_runtime.h>
#include <hip/hip_cooperative_groups.h>
#include <cstdio>
#include <cstdint>
#include <type_traits>
namespace cg = cooperative_groups;

#define DI __device__ __forceinline__
typedef unsigned short bf16_t;
typedef short bf16x8 __attribute__((ext_vector_type(8)));
typedef short s16x4 __attribute__((ext_vector_type(4)));
typedef float f32x16 __attribute__((ext_vector_type(16)));
typedef float f32x4 __attribute__((ext_vector_type(4)));
typedef float f32x2 __attribute__((ext_vector_type(2)));
typedef __bf16 bf2_t __attribute__((ext_vector_type(2)));
typedef __attribute__((address_space(3))) s16x4 lds_s16x4;
typedef __attribute__((address_space(3))) void lds_void;

constexpr int REP_P1 = 1, REP_P3 = 1, REP_SSM = 1, REP_P56 = 1;
constexpr int SEQ = 8192, NTOK = 16384, DM = 2048, DIN = 6144;
constexpr float LOG2E = 1.4426950408889634f;
constexpr float QSCALE = 0.125f * LOG2E;
constexpr int NTHR = 512;
constexpr int LDS_BYTES = 148752;
constexpr int XBW_OFF = 148736;
constexpr int ATT_STAGE = 32768;
constexpr int ATT_VOFF = 16384;
constexpr int BT_OFF = 147456;

struct Params {
  const float *x, *rel_bias, *pre_g, *post_g, *w_in, *lq1, *lk1, *lq2, *lk2, *subln_g, *a_re, *a_im, *log_dt,
      *b_re, *b_im, *c_re, *c_im, *ssm_d, *w_glu, *w_out;
  float* out;
  bf16_t *wb_in, *wb_glu, *wb_out, *proj, *mixin, *ybuf, *mix, *xb, *xlo, *Kc, *Wst, *Wo, *Hb;
  float *rstd, *lam, *E, *lamL, *zero;
  unsigned* bar;
  unsigned long long use_cg;
};

DI int ltid() { int t = threadIdx.x; asm volatile("" : "+v"(t)); return t; }
DI int crow(int r, int h) { return (r & 3) + 8 * (r >> 2) + 4 * h; }
DI float bf2f(bf16_t u) { return __uint_as_float(((unsigned)u) << 16); }
DI unsigned pk2(float a, float b) { f32x2 v = {a, b}; bf2_t r = __builtin_convertvector(v, bf2_t); return __builtin_bit_cast(unsigned, r); }
DI bf16_t f2bf(float a) { return (bf16_t)(pk2(a, 0.f) & 0xffffu); }
DI float wave_sum(float v) {
#pragma unroll
  for (int o = 32; o >= 1; o >>= 1) v += __shfl_xor(v, o);
  return v;
}
DI float silu_f(float v) { return v * __builtin_amdgcn_rcpf(1.f + __expf(-v)); }
DI float sigmoid_f(float v) { return __builtin_amdgcn_rcpf(1.f + __expf(-v)); }
DI float gelu_tanh_f(float v) { const float u = 1.5957691216057308f * (v + 0.044715f * v * v * v); return v * __builtin_amdgcn_rcpf(1.f + __expf(-u)); }
DI f32x16 mfma32(bf16x8 a, bf16x8 b, f32x16 c) { return __builtin_amdgcn_mfma_f32_32x32x16_bf16(a, b, c, 0, 0, 0); }
DI s16x4 tr_read(const char* p) { return __builtin_amdgcn_ds_read_tr16_b64_v4i16((lds_s16x4*)p); }


#define XB_TMO      128
#define XB_XCNT(j)  (256  + 64 * (j))
#define XB_XSUB(j)  (1280 + 64 * (j))
#define XB_XGEN(j)  (2304 + 64 * (j))
#define XB_TOP      3328
#define XB_TOPGEN   3392
#define XCD_BAR_WORDS 3456
#define XB_SPIN_CAP (1u << 22)
#define LAS __attribute__((address_space(3)))
DI unsigned xb_ld(unsigned* p) { return __hip_atomic_load(p, __ATOMIC_RELAXED, __HIP_MEMORY_SCOPE_AGENT); }
DI unsigned xb_add(unsigned* p, unsigned v) { return __hip_atomic_fetch_add(p, v, __ATOMIC_RELAXED, __HIP_MEMORY_SCOPE_AGENT); }
DI unsigned xb_xcc_id() { return (unsigned)__builtin_amdgcn_s_getreg((3 << 11) | 20) & 0xFu; }
#define XB_SPIN(cond, bar) do { unsigned _sp = 0; while (cond) { __builtin_amdgcn_s_sleep(1); \
    if ((++_sp & 255u) == 0u) { if (xb_ld(&(bar)[XB_TMO])) break; if (_sp > XB_SPIN_CAP) { atomicAdd(&(bar)[XB_TMO], 1u); break; } } } } while (0)
struct XcdBarrier { unsigned* bar; unsigned x; volatile LAS unsigned* st; };
DI XcdBarrier xcd_barrier_post(unsigned* bar, volatile LAS unsigned* st) {
  XcdBarrier b; b.bar = bar; b.x = xb_xcc_id(); b.st = st;
  if (threadIdx.x == 0) (void)xb_add(&bar[XB_XCNT(b.x)], 1u);
  return b;
}
DI void xcd_barrier_complete(unsigned* bar, unsigned x, unsigned& nloc, unsigned& nx) {
  const unsigned G = gridDim.x * gridDim.y * gridDim.z;
  unsigned sum, cnt, mine, sp = 0u;
  for (;;) {
    sum = 0u; cnt = 0u; mine = 0u;
#pragma unroll
    for (unsigned j = 0; j < 16; ++j) { const unsigned c = xb_ld(&bar[XB_XCNT(j)]); sum += c; cnt += (c > 0u) ? 1u : 0u; mine = (j == x) ? c : mine; }
    if (sum == G) break;
    __builtin_amdgcn_s_sleep(1);
    if ((++sp & 255u) == 0u) { if (xb_ld(&bar[XB_TMO])) break; if (sp > XB_SPIN_CAP) { atomicAdd(&bar[XB_TMO], 1u); break; } }
  }
  nloc = mine > 0u ? mine : 1u; nx = cnt > 0u ? cnt : 1u;
}
DI void xcd_barrier(const XcdBarrier& b) {
  asm volatile("s_waitcnt vmcnt(0)" ::: "memory");
  __syncthreads();
  if (threadIdx.x == 0) {
    unsigned* bar = b.bar;
    unsigned bx = b.x; asm volatile("" : "+s"(bx));
    __builtin_amdgcn_s_waitcnt(0);
    unsigned nloc = b.st[0], nx = b.st[1];
    if (nloc == 0u) { xcd_barrier_complete(bar, bx, nloc, nx); b.st[0] = nloc; b.st[1] = nx; }
    const unsigned old = xb_add(&bar[XB_XSUB(bx)], 1u);
    const unsigned gen = old / nloc;
    if (old + 1u == (gen + 1u) * nloc) {
      __builtin_amdgcn_fence(__ATOMIC_RELEASE, "agent");
      asm volatile("s_waitcnt vmcnt(0)" ::: "memory");
      const unsigned og = xb_add(&bar[XB_TOP], 1u);
      const unsigned tg = og / nx;
      if (og + 1u == (tg + 1u) * nx) xb_add(&bar[XB_TOPGEN], 1u);
      else XB_SPIN(xb_ld(&bar[XB_TOPGEN]) == tg, bar);
      __builtin_amdgcn_fence(__ATOMIC_ACQUIRE, "agent");
      xb_add(&bar[XB_XGEN(bx)], 1u);
      asm volatile("s_waitcnt vmcnt(0)" ::: "memory");
    } else {
      XB_SPIN(xb_ld(&bar[XB_XGEN(bx)]) == gen, bar);
      __builtin_amdgcn_fence(__ATOMIC_ACQUIRE, "agent");
      asm volatile("s_waitcnt vmcnt(0)" ::: "memory");
    }
  }
  __syncthreads();
}

template <int WM, int WN, int MT, bool TR, int NSTG, class LA, class LB, class EPI>
DI void gemm_tile(char* lds, const char* gbase, int nk, LA la, LB lb, EPI epi) {
  static_assert(WM * WN == 8, "8 waves");
  static_assert(NSTG == 3 || NSTG == 4, "stages");
  constexpr int BM = WM * 32 * MT, BN = WN * 64, NA = BM / 64, NB = BN / 64, NL = NA + NB, BOFF = BM * 128, STG = BOFF + BN * 128;
  static_assert(NSTG * STG <= 147456, "LDS stage area");
  int tid_ = threadIdx.x; asm volatile("" : "+v"(tid_));
  const int tid = tid_, lane = tid & 63, wave = tid >> 6, wm = wave / WN, wn = wave % WN;
  const int l31 = lane & 31, h = lane >> 5;
  const int lr = lane >> 3, gch = lane & 7;
  f32x16 acc[MT][2];
#pragma unroll
  for (int i = 0; i < MT; ++i)
#pragma unroll
    for (int j = 0; j < 2; ++j)
#pragma unroll
      for (int r = 0; r < 16; ++r) acc[i][j][r] = 0.f;
  const __amdgpu_buffer_rsrc_t rsrc = __builtin_amdgcn_make_buffer_rsrc((void*)gbase, (short)0, 0x7fffffff, 0x00020000);
  auto piece = [&](int kt, int st, int i) {
    char* base = lds + st * STG;
    if (i < NA) {
      const int row = 8 * (wave * NA + i) + lr;
      const int c = gch ^ ((row >> 1) & 7);
      __builtin_amdgcn_raw_ptr_buffer_load_lds(rsrc, (lds_void*)(base + (wave * NA + i) * 1024), 16, la(row, c, kt), 0, 0, 0);
    } else {
      const int i2 = i - NA;
      const int row = 8 * (wave * NB + i2) + lr;
      const int c = gch ^ ((row >> 1) & 7);
      __builtin_amdgcn_raw_ptr_buffer_load_lds(rsrc, (lds_void*)(base + BOFF + (wave * NB + i2) * 1024), 16, lb(row, c, kt), 0, 0, 0);
    }
  };
  const int xs = (l31 >> 1) & 7;
  const int arow = (wm * 32 * MT + l31) * 128, brow = BOFF + (wn * 64 + l31) * 128;
#pragma unroll
  for (int t = 0; t < NSTG - 1; ++t)
    if (t < nk) {
#pragma unroll
      for (int i = 0; i < NL; ++i) piece(t, t, i);
    }
  auto rd = [&](const char* a, int s, bf16x8 (&af)[MT], bf16x8 (&bf)[2]) {
    const int co = 16 * ((2 * s + h) ^ xs);
#pragma unroll
    for (int j = 0; j < 2; ++j) bf[j] = *(const bf16x8*)(a + brow + j * 4096 + co);
#pragma unroll
    for (int i = 0; i < MT; ++i) af[i] = *(const bf16x8*)(a + arow + i * 4096 + co);
  };
  int sc = 0;
#pragma unroll 1
  for (int kt = 0; kt < nk; ++kt) {
    if (NSTG >= 4 && kt + 2 < nk) asm volatile("s_waitcnt vmcnt(%0)" ::"n"(2 * NL) : "memory");
    else if (kt + 1 < nk) asm volatile("s_waitcnt vmcnt(%0)" ::"n"(NL) : "memory");
    else asm volatile("s_waitcnt vmcnt(0)" ::: "memory");
    __builtin_amdgcn_s_barrier();
    asm volatile("" ::: "memory");
    const bool more = (kt + NSTG - 1 < nk);
    const int sf = (sc == 0) ? NSTG - 1 : sc - 1;
    const char* a0 = lds + sc * STG;
    bf16x8 af0[MT], af1[MT], bf0[2], bf1[2];
    rd(a0, 0, af0, bf0);
    rd(a0, 1, af1, bf1);
    __builtin_amdgcn_sched_barrier(0);
#pragma unroll
    for (int s = 0; s < 4; ++s) {
      bf16x8 (&af)[MT] = (s & 1) ? af1 : af0;
      bf16x8 (&bf)[2] = (s & 1) ? bf1 : bf0;
#pragma unroll
      for (int i = 0; i < MT; ++i) {
        acc[i][0] = TR ? mfma32(bf[0], af[i], acc[i][0]) : mfma32(af[i], bf[0], acc[i][0]);
        acc[i][1] = TR ? mfma32(bf[1], af[i], acc[i][1]) : mfma32(af[i], bf[1], acc[i][1]);
        if (s < 2) {
          __builtin_amdgcn_sched_barrier(0);
          const int pi = s * MT + i;
          if (pi < NL) { if (more) piece(kt + NSTG - 1, sf, pi); }
          __builtin_amdgcn_sched_barrier(0);
        }
      }
      if (s == 1) {
#pragma unroll
        for (int pi = 2 * MT; pi < NL; ++pi) { if (more) piece(kt + NSTG - 1, sf, pi); }
      }
      __builtin_amdgcn_sched_barrier(0);
      if (s < 2) { rd(a0, s + 2, af, bf); __builtin_amdgcn_sched_barrier(0); }
    }
    sc = (sc == NSTG - 1) ? 0 : sc + 1;
  }
  epi(acc, wm, wn, l31, h);
  __syncthreads();
}

typedef float f32x4v __attribute__((ext_vector_type(4)));
DI f32x4v mfma16(bf16x8 a, bf16x8 b, f32x4v c) { return __builtin_amdgcn_mfma_f32_16x16x32_bf16(a, b, c, 0, 0, 0); }
template <class LA, class LB, class EPI>
DI void gemm_tile16(char* lds, const char* gbase, int nk, LA la, LB lb, EPI epi) {
  constexpr int STG = 65536, BOFF = 32768, NL = 8;
  int tid_ = threadIdx.x; asm volatile("" : "+v"(tid_));
  const int tid = tid_, lane = tid & 63, wave = tid >> 6, wm = wave >> 2, wn = wave & 3;
  const int l15 = lane & 15, q4 = lane >> 4;
  const int lr = lane >> 3, gch = lane & 7;
  f32x4v acc[8][4];
#pragma unroll
  for (int i = 0; i < 8; ++i)
#pragma unroll
    for (int j = 0; j < 4; ++j)
#pragma unroll
      for (int e = 0; e < 4; ++e) acc[i][j][e] = 0.f;
  const __amdgpu_buffer_rsrc_t rsrc = __builtin_amdgcn_make_buffer_rsrc((void*)gbase, (short)0, 0x7fffffff, 0x00020000);
  auto piece = [&](int kt, int i) {
    char* base = lds + (kt & 1) * STG;
    if (i < 4) {
      const int row = 8 * (wave * 4 + i) + lr;
      const int c = gch ^ ((row >> 1) & 7);
      __builtin_amdgcn_raw_ptr_buffer_load_lds(rsrc, (lds_void*)(base + (wave * 4 + i) * 1024), 16, la(row, c, kt), 0, 0, 0);
    } else {
      const int i2 = i - 4;
      const int row = 8 * (wave * 4 + i2) + lr;
      const int c = gch ^ ((row >> 1) & 7);
      __builtin_amdgcn_raw_ptr_buffer_load_lds(rsrc, (lds_void*)(base + BOFF + (wave * 4 + i2) * 1024), 16, lb(row, c, kt), 0, 0, 0);
    }
  };
  const int xs = (l15 >> 1) & 7;
  const int arow = (wm * 128 + l15) * 128, brow = BOFF + (wn * 64 + l15) * 128;
  const int co0 = 16 * (q4 ^ xs), co1 = 16 * ((4 + q4) ^ xs);
#pragma unroll
  for (int i = 0; i < NL; ++i) piece(0, i);
  auto rdB = [&](const char* a, int co, bf16x8 (&bf)[4]) {
#pragma unroll
    for (int j = 0; j < 4; ++j) bf[j] = *(const bf16x8*)(a + brow + j * 2048 + co);
  };
  auto rdA = [&](const char* a, int co, int half, bf16x8 (&af)[4]) {
#pragma unroll
    for (int i = 0; i < 4; ++i) af[i] = *(const bf16x8*)(a + arow + (half * 4 + i) * 2048 + co);
  };
#pragma unroll 1
  for (int kt = 0; kt < nk; ++kt) {
    asm volatile("s_waitcnt vmcnt(0)" ::: "memory");
    __builtin_amdgcn_s_barrier();
    asm volatile("" ::: "memory");
    const bool more = (kt + 1 < nk);
    const char* a0 = lds + (kt & 1) * STG;
    bf16x8 B0[4], B1[4], Alo[4], Ahi[4];
    Alo[0] = *(const bf16x8*)(a0 + arow + co0);
    rdB(a0, co0, B0);
#pragma unroll
    for (int i = 1; i < 4; ++i) Alo[i] = *(const bf16x8*)(a0 + arow + i * 2048 + co0);
    rdA(a0, co0, 1, Ahi);
    __builtin_amdgcn_sched_barrier(0);
#pragma unroll
    for (int i = 0; i < 4; ++i) {
#pragma unroll
      for (int j = 0; j < 4; ++j) acc[i][j] = mfma16(B0[j], Alo[i], acc[i][j]);
      __builtin_amdgcn_sched_barrier(0);
      if (more) piece(kt + 1, i);
      __builtin_amdgcn_sched_barrier(0);
    }
    rdB(a0, co1, B1);
    rdA(a0, co1, 0, Alo);
    __builtin_amdgcn_sched_barrier(0);
#pragma unroll
    for (int i = 0; i < 4; ++i) {
#pragma unroll
      for (int j = 0; j < 4; ++j) acc[4 + i][j] = mfma16(B0[j], Ahi[i], acc[4 + i][j]);
      __builtin_amdgcn_sched_barrier(0);
      if (more) piece(kt + 1, 4 + i);
      __builtin_amdgcn_sched_barrier(0);
    }
    rdA(a0, co1, 1, Ahi);
    __builtin_amdgcn_sched_barrier(0);
#pragma unroll
    for (int i = 0; i < 4; ++i)
#pragma unroll
      for (int j = 0; j < 4; ++j) acc[i][j] = mfma16(B1[j], Alo[i], acc[i][j]);
    __builtin_amdgcn_sched_barrier(0);
#pragma unroll
    for (int i = 0; i < 4; ++i)
#pragma unroll
      for (int j = 0; j < 4; ++j) acc[4 + i][j] = mfma16(B1[j], Ahi[i], acc[4 + i][j]);
  }
  epi(acc, wm, wn, l15, q4);
  __syncthreads();
}

DI void wconv_item(const float* __restrict__ src, int K, int N, bf16_t* __restrict__ dst, const float* __restrict__ gain,
                   int glu_perm, int kt, int ng, char* lds) {
  float* tile = (float*)lds;
  int tid_ = threadIdx.x; asm volatile("" : "+v"(tid_));
  const int tid = tid_;
  __syncthreads();
  f32x4 v[8];
#pragma unroll
  for (int i = 0; i < 8; ++i) {
    const int kk = i * 8 + (tid >> 6), n4 = (tid & 63) * 4;
    const int np = ng * 256 + n4;
    int sc = np;
    if (glu_perm) { const int blk = np >> 6, w = np & 63; const int j = blk * 32 + (w & 31); sc = (w < 32) ? j : 1024 + j; }
    v[i] = *(const f32x4*)(src + (size_t)(kt * 64 + kk) * N + sc);
  }
#pragma unroll
  for (int i = 0; i < 8; ++i) {
    const int kk = i * 8 + (tid >> 6), n4 = (tid & 63) * 4;
    if (gain) { const float gg = gain[kt * 64 + kk]; v[i][0] *= gg; v[i][1] *= gg; v[i][2] *= gg; v[i][3] *= gg; }
    *(f32x4*)(tile + kk * 260 + n4) = v[i];
  }
  __syncthreads();
#pragma unroll
  for (int i = 0; i < 4; ++i) {
    const int nn = (tid & 63) + 64 * (i & 3), kc = tid >> 6;
    uint4 w;
    w.x = pk2(tile[(kc * 8 + 0) * 260 + nn], tile[(kc * 8 + 1) * 260 + nn]);
    w.y = pk2(tile[(kc * 8 + 2) * 260 + nn], tile[(kc * 8 + 3) * 260 + nn]);
    w.z = pk2(tile[(kc * 8 + 4) * 260 + nn], tile[(kc * 8 + 5) * 260 + nn]);
    w.w = pk2(tile[(kc * 8 + 6) * 260 + nn], tile[(kc * 8 + 7) * 260 + nn]);
    *(uint4*)(dst + (size_t)(ng * 256 + nn) * K + kt * 64 + kc * 8) = w;
  }
}

DI void xprep_row(const float* __restrict__ x, int row, bf16_t* __restrict__ xb, float* __restrict__ rstd) {
  const int lane = ltid() & 63;
  const float* src = x + (size_t)row * DM;
  float ss = 0.f;
#pragma unroll
  for (int i = 0; i < 4; ++i) {
    const int c = lane * 8 + 512 * i;
    const f32x4 a = *(const f32x4*)(src + c), b = *(const f32x4*)(src + c + 4);
    ss += a[0] * a[0] + a[1] * a[1] + a[2] * a[2] + a[3] * a[3] + b[0] * b[0] + b[1] * b[1] + b[2] * b[2] + b[3] * b[3];
    uint4 w; w.x = pk2(a[0], a[1]); w.y = pk2(a[2], a[3]); w.z = pk2(b[0], b[1]); w.w = pk2(b[2], b[3]);
    *(uint4*)(xb + (size_t)row * DM + c) = w;
  }
  ss = wave_sum(ss);
  if (lane == 0) rstd[row] = rsqrtf(ss * (1.f / DM) + 1e-6f);
}

DI void ssm_prep_item(const Params& p, int l, int g, char* lds) {
  float* pwre = (float*)lds;
  float* pwim = pwre + 65 * 65;
  float* Bre = pwim + 65 * 65;
  float* Bim = Bre + 1024;
  float* Cre = Bim + 1024;
  float* Cim = Cre + 1040;
  float* cfre = Cim + 1040;
  float* cfim = cfre + 64;
  int tid_ = threadIdx.x; asm volatile("" : "+v"(tid_));
  const int tid = tid_;
  const int lg = l * 64 + g;
  __syncthreads();
  if (tid < 64) {
    const int pp = tid;
    const double dt = exp((double)p.log_dt[lg]);
    const double ar = p.a_re[lg * 64 + pp], ai = p.a_im[lg * 64 + pp];
    const double mag = exp(dt * ar), lr = mag * cos(dt * ai), li = mag * sin(dt * ai);
    const double den = ar * ar + ai * ai, nr = lr - 1.0;
    cfre[pp] = (float)((nr * ar + li * ai) / den);
    cfim[pp] = (float)((li * ar - nr * ai) / den);
    double wr = 1.0, wi = 0.0;
#pragma unroll 1
    for (int t = 0; t <= 64; ++t) {
      pwre[t * 65 + pp] = (float)wr; pwim[t * 65 + pp] = (float)wi;
      const double n2 = wr * lr - wi * li; wi = wr * li + wi * lr; wr = n2;
    }
    p.lamL[(lg * 64 + pp) * 2] = pwre[64 * 65 + pp];
    p.lamL[(lg * 64 + pp) * 2 + 1] = pwim[64 * 65 + pp];
  }
  for (int e = tid; e < 1024; e += NTHR) { Cre[(e >> 6) * 65 + (e & 63)] = p.c_re[lg * 1024 + e]; Cim[(e >> 6) * 65 + (e & 63)] = p.c_im[lg * 1024 + e]; }
  if (l == 0 && g == 0 && tid < 64) p.zero[tid] = 0.f;
  if (g == 0 && tid == 0) {
    float s1 = 0.f, s2 = 0.f;
    for (int i = 0; i < 64; ++i) { s1 += p.lq1[l * 64 + i] * p.lk1[l * 64 + i]; s2 += p.lq2[l * 64 + i] * p.lk2[l * 64 + i]; }
    const float lam_init = 0.8f - 0.6f * expf(-0.3f * (float)l);
    p.lam[l] = expf(s1) - expf(s2) + lam_init;
  }
  __syncthreads();
  for (int e = tid; e < 1024; e += NTHR) {
    const int pp = e >> 4;
    const float br = p.b_re[lg * 1024 + e], bi = p.b_im[lg * 1024 + e];
    Bre[e] = cfre[pp] * br - cfim[pp] * bi;
    Bim[e] = cfre[pp] * bi + cfim[pp] * br;
  }
  __syncthreads();
#pragma unroll 1
  for (int q = 0; q < 2; ++q) {
    const int idx = tid + NTHR * q, co = idx >> 6, tau = idx & 63;
    float acc[16];
#pragma unroll
    for (int c = 0; c < 16; ++c) acc[c] = 0.f;
#pragma unroll 2
    for (int pp = 0; pp < 64; ++pp) {
      const float cr = Cre[co * 65 + pp], ci = Cim[co * 65 + pp], wr = pwre[tau * 65 + pp], wi = pwim[tau * 65 + pp];
      const float xr = cr * wr - ci * wi, xi = cr * wi + ci * wr;
#pragma unroll
      for (int c = 0; c < 16; ++c) acc[c] += xr * Bre[pp * 16 + c] - xi * Bim[pp * 16 + c];
    }
    uint4 w0, w1;
    w0.x = pk2(acc[0], acc[1]); w0.y = pk2(acc[2], acc[3]); w0.z = pk2(acc[4], acc[5]); w0.w = pk2(acc[6], acc[7]);
    w1.x = pk2(acc[8], acc[9]); w1.y = pk2(acc[10], acc[11]); w1.z = pk2(acc[12], acc[13]); w1.w = pk2(acc[14], acc[15]);
    bf16_t* d = p.Kc + ((size_t)(lg * 16 + co) * 64 + tau) * 16;
    *(uint4*)d = w0; *(uint4*)(d + 8) = w1;
  }
#pragma unroll 1
  for (int q = 0; q < 16; ++q) {
    const int idx = tid + NTHR * q, pr = idx >> 6, s = idx & 63, pp = pr & 63;
    const float wr = pwre[(63 - s) * 65 + pp], wi = pwim[(63 - s) * 65 + pp];
    float v[16];
#pragma unroll
    for (int c = 0; c < 16; ++c) {
      const float br = Bre[pp * 16 + c], bi = Bim[pp * 16 + c];
      v[c] = (pr < 64) ? (wr * br - wi * bi) : (wr * bi + wi * br);
    }
    uint4 w0, w1;
    w0.x = pk2(v[0], v[1]); w0.y = pk2(v[2], v[3]); w0.z = pk2(v[4], v[5]); w0.w = pk2(v[6], v[7]);
    w1.x = pk2(v[8], v[9]); w1.y = pk2(v[10], v[11]); w1.z = pk2(v[12], v[13]); w1.w = pk2(v[14], v[15]);
    bf16_t* d = p.Wst + ((size_t)(lg * 128 + pr)) * 1024 + s * 16;
    *(uint4*)d = w0; *(uint4*)(d + 8) = w1;
  }
#pragma unroll 1
  for (int q = 0; q < 32; ++q) {
    const int idx = tid + NTHR * q, m = idx >> 4, ch = idx & 15, t = m >> 4, co = m & 15;
    float v[8];
#pragma unroll
    for (int j = 0; j < 8; ++j) {
      const int pr = ch * 8 + j, pp = pr & 63;
      const float cr = Cre[co * 65 + pp], ci = Cim[co * 65 + pp], wr = pwre[(t + 1) * 65 + pp], wi = pwim[(t + 1) * 65 + pp];
      v[j] = (pr < 64) ? (cr * wr - ci * wi) : -(cr * wi + ci * wr);
    }
    uint4 w0;
    w0.x = pk2(v[0], v[1]); w0.y = pk2(v[2], v[3]); w0.z = pk2(v[4], v[5]); w0.w = pk2(v[6], v[7]);
    *(uint4*)(p.Wo + ((size_t)(lg * 1024 + m)) * 128 + ch * 8) = w0;
  }
}

typedef unsigned u32x4 __attribute__((ext_vector_type(4)));

DI bf16x8 v_frag(const char* a0, const char* a1) {
  const s16x4 lo = tr_read(a0);
  const s16x4 hi = tr_read(a1);
  return __builtin_shufflevector(lo, hi, 0, 1, 2, 3, 4, 5, 6, 7);
}

template <bool NEAR>
DI void attn_tile(const char* kb, const bf16x8 (&q)[4], f32x16 (&O)[4], float& mrun, float& lsum,
                  const float* btab, int relb, float cfar, int ko0, int ko1, int ko2, int ko3, int vA0, int vA1, bool first, f32x16& I) {
  f32x16 S0, S1;
  auto comp_s = [&]() {
    const bf16x8 k00 = *(const bf16x8*)(kb + ko0), k10 = *(const bf16x8*)(kb + ko0 + 8192);
    const bf16x8 k01 = *(const bf16x8*)(kb + ko1), k11 = *(const bf16x8*)(kb + ko1 + 8192);
    const bf16x8 k02 = *(const bf16x8*)(kb + ko2), k12 = *(const bf16x8*)(kb + ko2 + 8192);
    const bf16x8 k03 = *(const bf16x8*)(kb + ko3), k13 = *(const bf16x8*)(kb + ko3 + 8192);
    __builtin_amdgcn_sched_barrier(0);
    S0 = mfma32(k00, q[0], I); S1 = mfma32(k10, q[0], I);
    S0 = mfma32(k01, q[1], S0); S1 = mfma32(k11, q[1], S1);
    S0 = mfma32(k02, q[2], S0); S1 = mfma32(k12, q[2], S1);
    S0 = mfma32(k03, q[3], S0); S1 = mfma32(k13, q[3], S1);
    if (NEAR) {
#pragma unroll
      for (int r = 0; r < 16; ++r) {
        S0[r] += btab[relb + (r & 3) + 8 * (r >> 2)];
        S1[r] += btab[relb + 32 + (r & 3) + 8 * (r >> 2)];
      }
    }
  };
  comp_s();
  const char* vb = kb + ATT_VOFF;
  bool need = first;
  float ps = 0.f;
  if (!first) {
#pragma unroll
    for (int r = 0; r < 16; ++r) {
      S0[r] = __builtin_amdgcn_exp2f(S0[r]); S1[r] = __builtin_amdgcn_exp2f(S1[r]);
      ps += S0[r];
      ps += S1[r];
    }
    need = __any(!(ps <= 1048576.f));
  }
  if (need) {
    if (!first) comp_s();
    float tmax = fmaxf(S0[0], S1[0]);
#pragma unroll
    for (int r = 1; r < 16; ++r) tmax = fmaxf(tmax, fmaxf(S0[r], S1[r]));
    tmax = fmaxf(tmax, __shfl_xor(tmax, 32));
    const float d = first ? tmax : fmaxf(tmax, 0.f);
    const float alpha = __builtin_amdgcn_exp2f(-d);
#pragma unroll
    for (int dd = 0; dd < 4; ++dd)
#pragma unroll
      for (int r = 0; r < 16; ++r) O[dd][r] *= alpha;
    lsum *= alpha;
    mrun += d;
#pragma unroll
    for (int r = 0; r < 16; ++r) I[r] = cfar - mrun;
    ps = 0.f;
#pragma unroll
    for (int r = 0; r < 16; ++r) {
      S0[r] = __builtin_amdgcn_exp2f(S0[r] - d); S1[r] = __builtin_amdgcn_exp2f(S1[r] - d);
      ps += S0[r];
      ps += S1[r];
    }
  }
  lsum += ps;
  u32x4 u;
  u[0] = pk2(S0[0], S0[1]); u[1] = pk2(S0[2], S0[3]); u[2] = pk2(S0[4], S0[5]); u[3] = pk2(S0[6], S0[7]);
  const bf16x8 p00 = __builtin_bit_cast(bf16x8, u);
  u[0] = pk2(S0[8], S0[9]); u[1] = pk2(S0[10], S0[11]); u[2] = pk2(S0[12], S0[13]); u[3] = pk2(S0[14], S0[15]);
  const bf16x8 p01 = __builtin_bit_cast(bf16x8, u);
  u[0] = pk2(S1[0], S1[1]); u[1] = pk2(S1[2], S1[3]); u[2] = pk2(S1[4], S1[5]); u[3] = pk2(S1[6], S1[7]);
  const bf16x8 p10 = __builtin_bit_cast(bf16x8, u);
  u[0] = pk2(S1[8], S1[9]); u[1] = pk2(S1[10], S1[11]); u[2] = pk2(S1[12], S1[13]); u[3] = pk2(S1[14], S1[15]);
  const bf16x8 p11 = __builtin_bit_cast(bf16x8, u);
#pragma unroll
  for (int d = 0; d < 4; ++d) {
    const int x0 = vA0 ^ (d << 6), x1 = vA1 ^ (d << 6);
    const bf16x8 f0 = v_frag(vb + x0, vb + x1);
    const bf16x8 f1 = v_frag(vb + x0 + 16 * 256, vb + x1 + 16 * 256);
    const bf16x8 f2 = v_frag(vb + x0 + 32 * 256, vb + x1 + 32 * 256);
    const bf16x8 f3 = v_frag(vb + x0 + 48 * 256, vb + x1 + 48 * 256);
    __builtin_amdgcn_sched_barrier(0);
    O[d] = mfma32(f0, p00, O[d]);
    O[d] = mfma32(f1, p01, O[d]);
    O[d] = mfma32(f2, p10, O[d]);
    O[d] = mfma32(f3, p11, O[d]);
  }
}

DI void attn_item(const Params& p, const char* wsb, int l, int item, char* lds) {
  int tid_ = threadIdx.x; asm volatile("" : "+v"(tid_));
  const int tid = tid_, lane = tid & 63, w = tid >> 6, l31 = lane & 31, h = lane >> 5;
  const int rg = w & 3, mp = w >> 2;
  const int b = item >> 8, hd = item & 7, pi = (item >> 3) & 31;
  const __amdgpu_buffer_rsrc_t rsrc = __builtin_amdgcn_make_buffer_rsrc((void*)wsb, (short)0, 0x7fffffff, 0x00020000);
  float* btab = (float*)(lds + BT_OFF);
  const float lam = p.lam[l];
  const float lam_init = 0.8f - 0.6f * __expf(-0.3f * (float)l);
  __syncthreads();
  for (int i = tid; i < 320; i += NTHR) {
    const int rel = i - 255;
    const int n = rel < 0 ? -rel : rel;
    int bk = n < 8 ? n : (n < 12 ? 8 : (n < 16 ? 9 : (n < 23 ? 10 : (n < 32 ? 11 : (n < 46 ? 12 : (n < 64 ? 13 : (n < 91 ? 14 : 15)))))));
    if (rel > 0) bk += 16;
    btab[i] = (p.rel_bias[bk * 8 + hd] - p.rel_bias[15 * 8 + hd]) * LOG2E;
  }
  const float cfar = p.rel_bias[15 * 8 + hd] * LOG2E;
  const size_t rowbase = (size_t)b * SEQ;
  const int swk = ((l31 & 3) << 2) | ((l31 >> 2) & 3);
  const int ko0 = l31 * 256 + 16 * ((mp * 8 + 0 + h) ^ swk), ko1 = l31 * 256 + 16 * ((mp * 8 + 2 + h) ^ swk);
  const int ko2 = l31 * 256 + 16 * ((mp * 8 + 4 + h) ^ swk), ko3 = l31 * 256 + 16 * ((mp * 8 + 6 + h) ^ swk);
  const int q4 = (lane & 15) >> 2, pp = lane & 3, blk = (lane >> 4) & 1;
  const int vA0 = (4 * h + q4) * 256 + 8 * (pp & 1) + 16 * ((blk * 2 + (pp >> 1)) ^ h) + (q4 << 6);
  const int vA1 = (4 * h + 8 + q4) * 256 + 8 * (pp & 1) + 16 * ((blk * 2 + (pp >> 1)) ^ (h + 2)) + (q4 << 6);
  const int srow = 8 * w + (lane >> 4);
  const int lch = lane & 15;

#pragma unroll 1
  for (int half = 0; half < 2; ++half) {
    const int qb = half ? pi : 63 - pi;
    const int q0 = qb * 128, nkt = 2 * qb + 2;
    const int qrow = q0 + 32 * rg + l31;
    const bf16_t* qptr = p.proj + (rowbase + qrow) * DIN + hd * 128 + mp * 64 + h * 8;
    bf16x8 q[4];
#pragma unroll
    for (int s = 0; s < 4; ++s) q[s] = *(const bf16x8*)(qptr + s * 16);
    f32x16 O[4];
#pragma unroll
    for (int d = 0; d < 4; ++d)
#pragma unroll
      for (int r = 0; r < 16; ++r) O[d][r] = 0.f;
    float mrun = 0.f, lsum = 0.f;
    f32x16 I;
#pragma unroll
    for (int r = 0; r < 16; ++r) I[r] = cfar;
    const unsigned kbase = (unsigned)((const char*)(p.proj + rowbase * DIN + 1024 + hd * 128) - wsb);
    auto stage = [&](int kt, int st) {
      char* base = lds + st * ATT_STAGE + w * 2048;
      const unsigned soff = kbase + (unsigned)kt * (64 * DIN * 2);
#pragma unroll
      for (int i = 0; i < 2; ++i) {
        const int row = srow + 4 * i;
        const int c = lch ^ ((((lane >> 4) & 3) << 2) | ((2 * w + i) & 3));
        const unsigned off = (unsigned)((row * DIN + c * 8) * 2);
        __builtin_amdgcn_raw_ptr_buffer_load_lds(rsrc, (lds_void*)(base + i * 1024), 16, off, soff, 0, 0);
        __builtin_amdgcn_raw_ptr_buffer_load_lds(rsrc, (lds_void*)(base + ATT_VOFF + i * 1024), 16, off, soff + 2048u, 0, 0);
      }
    };
    asm volatile("s_waitcnt vmcnt(0)" ::: "memory");
    __syncthreads();
    stage(0, 0);
    asm volatile("s_waitcnt vmcnt(0)" ::: "memory");
    __syncthreads();
    auto step = [&](int kt, auto nearc) {
      constexpr bool NEAR = decltype(nearc)::value;
      if (kt + 1 < nkt) stage(kt + 1, (kt + 1) & 1);
      const char* kb = lds + (kt & 1) * ATT_STAGE;
      const int relb = kt * 64 - qrow + 255 + 4 * h;
      if (kt + 1 < nkt || rg >= 2)
        attn_tile<NEAR>(kb, q, O, mrun, lsum, btab, relb, cfar, ko0, ko1, ko2, ko3, vA0, vA1, kt == 0, I);
      asm volatile("s_waitcnt vmcnt(0)" ::: "memory");
      __syncthreads();
    };
    const int nfar = nkt - 4;
    int kt = 0;
#pragma unroll 1
    for (; kt < nfar; ++kt) step(kt, std::false_type{});
#pragma unroll 1
    for (; kt < nkt; ++kt) step(kt, std::true_type{});
    const float lt = lsum + __shfl_xor(lsum, 32);
    int lane2 = lane; asm volatile("" : "+v"(lane2));
    const int h2 = lane2 >> 5;
    float* xch = (float*)lds + (rg * 64) * 64 + lane2;
    if (mp == 1) {
      const float sc = lam / lt;
#pragma unroll
      for (int d = 0; d < 4; ++d)
#pragma unroll
        for (int r = 0; r < 16; ++r) xch[(d * 16 + r) * 64] = O[d][r] * sc;
    }
    __syncthreads();
    if (mp == 0) {
      const float i0 = 1.f / lt;
      float ssq = 0.f;
#pragma unroll
      for (int d = 0; d < 4; ++d)
#pragma unroll
        for (int r = 0; r < 16; ++r) { const float o = O[d][r] * i0 - xch[(d * 16 + r) * 64]; O[d][r] = o; ssq += o * o; }
      ssq += __shfl_xor(ssq, 32);
      const float rn = rsqrtf(ssq * (1.f / 128.f) + 1e-6f) * (1.f - lam_init);
      const size_t trow = rowbase + q0 + 32 * rg + (lane2 & 31);
      const float* gsp = p.subln_g + l * 128 + 4 * h2;
      const bf16_t* zp = p.proj + trow * DIN + 3072 + hd * 128 + 4 * h2;
      bf16_t* op = p.mixin + trow * DM + hd * 128 + 4 * h2;
#pragma unroll
      for (int d = 0; d < 4; ++d)
#pragma unroll
        for (int g4 = 0; g4 < 4; ++g4) {
          const int dv0 = d * 32 + 8 * g4;
          const f32x4 gs = *(const f32x4*)(gsp + dv0);
          const uint2 z = *(const uint2*)(zp + dv0);
          const float o0 = O[d][4 * g4 + 0] * rn * gs[0] * __uint_as_float(z.x << 16);
          const float o1 = O[d][4 * g4 + 1] * rn * gs[1] * __uint_as_float(z.x & 0xffff0000u);
          const float o2 = O[d][4 * g4 + 2] * rn * gs[2] * __uint_as_float(z.y << 16);
          const float o3 = O[d][4 * g4 + 3] * rn * gs[3] * __uint_as_float(z.y & 0xffff0000u);
          uint2 o; o.x = pk2(o0, o1); o.y = pk2(o2, o3);
          *(uint2*)(op + dv0) = o;
        }
    }
  }
}

DI void resid_row(const Params& p, int l, int row) {
  const int lane = ltid() & 63;
  const bf16_t* mix = p.mix + (size_t)row * DM;
  const float* gp = p.post_g + l * DM;
  float mv[4][8];
  float xv[4][8];
  float ss = 0.f;
#pragma unroll
  for (int i = 0; i < 4; ++i) {
    const int c = lane * 8 + 512 * i;
    const uint4 u = *(const uint4*)(mix + c);
    mv[i][0] = __uint_as_float(u.x << 16); mv[i][1] = __uint_as_float(u.x & 0xffff0000u);
    mv[i][2] = __uint_as_float(u.y << 16); mv[i][3] = __uint_as_float(u.y & 0xffff0000u);
    mv[i][4] = __uint_as_float(u.z << 16); mv[i][5] = __uint_as_float(u.z & 0xffff0000u);
    mv[i][6] = __uint_as_float(u.w << 16); mv[i][7] = __uint_as_float(u.w & 0xffff0000u);
    if (l == 0) {
      const f32x4 xa = *(const f32x4*)(p.x + (size_t)row * DM + c), xc = *(const f32x4*)(p.x + (size_t)row * DM + c + 4);
#pragma unroll
      for (int j = 0; j < 4; ++j) { xv[i][j] = xa[j]; xv[i][4 + j] = xc[j]; }
    } else {
      const uint4 hi = *(const uint4*)(p.xb + (size_t)row * DM + c);
      xv[i][0] = __uint_as_float(hi.x << 16); xv[i][1] = __uint_as_float(hi.x & 0xffff0000u);
      xv[i][2] = __uint_as_float(hi.y << 16); xv[i][3] = __uint_as_float(hi.y & 0xffff0000u);
      xv[i][4] = __uint_as_float(hi.z << 16); xv[i][5] = __uint_as_float(hi.z & 0xffff0000u);
      xv[i][6] = __uint_as_float(hi.w << 16); xv[i][7] = __uint_as_float(hi.w & 0xffff0000u);
    }
#pragma unroll
    for (int j = 0; j < 8; ++j) ss += mv[i][j] * mv[i][j];
  }
  ss = wave_sum(ss);
  const float rs = rsqrtf(ss * (1.f / DM) + 1e-6f);
  float s2 = 0.f;
#pragma unroll
  for (int i = 0; i < 4; ++i) {
    const int c = lane * 8 + 512 * i;
    const f32x4 ga = *(const f32x4*)(gp + c), gb = *(const f32x4*)(gp + c + 4);
    float y[8];
#pragma unroll
    for (int j = 0; j < 4; ++j) { y[j] = xv[i][j] + mv[i][j] * rs * ga[j]; y[4 + j] = xv[i][4 + j] + mv[i][4 + j] * rs * gb[j]; }
    if (l == 3) {
      f32x4 ya = {y[0], y[1], y[2], y[3]}, yb = {y[4], y[5], y[6], y[7]};
      *(f32x4*)(p.out + (size_t)row * DM + c) = ya; *(f32x4*)(p.out + (size_t)row * DM + c + 4) = yb;
    } else {
#pragma unroll
      for (int j = 0; j < 8; ++j) s2 += y[j] * y[j];
      uint4 w; w.x = pk2(y[0], y[1]); w.y = pk2(y[2], y[3]); w.z = pk2(y[4], y[5]); w.w = pk2(y[6], y[7]);
      *(uint4*)(p.xb + (size_t)row * DM + c) = w;
    }
  }
  if (l != 3) {
    s2 = wave_sum(s2);
    if (lane == 0) p.rstd[row] = rsqrtf(s2 * (1.f / DM) + 1e-6f);
  }
}

__global__ void __launch_bounds__(NTHR, 2) mega(Params p) {
  cg::grid_group grid = cg::this_grid();
  __shared__ __attribute__((aligned(16))) char lds[LDS_BYTES];
  const int G = gridDim.x, bid = blockIdx.x, tid = threadIdx.x;
  const char* wsb = (const char*)p.wb_in;
  if (tid == 0) *(uint4*)(lds + XBW_OFF) = make_uint4(0u, 0u, 0u, 0u);
  __syncthreads();
  const XcdBarrier xb = xcd_barrier_post(p.bar, (volatile LAS unsigned*)(lds + XBW_OFF));
  if (p.use_cg) grid.sync();

  for (int it = bid; it < 256 + 4608 + 2048; it += G) {
    if (it < 256) {
      ssm_prep_item(p, it >> 6, it & 63, lds);
    } else if (it < 256 + 4608) {
      const int j = it - 256, l = j / 1152, r = j % 1152;
      if (r < 768) wconv_item(p.w_in + (size_t)l * DM * DIN, DM, DIN, p.wb_in + (size_t)l * DIN * DM, p.pre_g + l * DM, 0, r / 24, r % 24, lds);
      else if (r < 896) { const int r2 = r - 768; wconv_item(p.w_glu + (size_t)l * 1024 * 2048, 1024, 2048, p.wb_glu + (size_t)l * 2048 * 1024, nullptr, 1, r2 / 8, r2 % 8, lds); }
      else { const int r3 = r - 896; wconv_item(p.w_out + (size_t)l * DM * DM, DM, DM, p.wb_out + (size_t)l * DM * DM, nullptr, 0, r3 / 8, r3 % 8, lds); }
    } else {
      const int row = (it - 256 - 4608) * 8 + (ltid() >> 6);
      xprep_row(p.x, row, p.xb, p.rstd);
    }
  }
  xcd_barrier(xb);

#pragma unroll 1
  for (int l = 0; l < 4; ++l) {
    {
      const bf16_t* A = p.xb;
      const bf16_t* Bt = p.wb_in + (size_t)l * DIN * DM;
      for (int rep = 0; rep < REP_P1; ++rep)
      for (int it = bid; it < 64 * 24; it += G) {
        const int mt = it / 24, nt = it % 24;
        const unsigned a0 = (unsigned)((const char*)(A + (size_t)mt * 256 * DM) - wsb);
        const unsigned b0 = (unsigned)((const char*)(Bt + (size_t)nt * 256 * DM) - wsb);
        auto la = [&](int row, int kc, int kt) { return a0 + (unsigned)((row * DM + kt * 64 + kc * 8) * 2); };
        auto lb = [&](int row, int kc, int kt) { return b0 + (unsigned)((row * DM + kt * 64 + kc * 8) * 2); };
        auto epi = [&](f32x4v (&acc)[8][4], int wm, int wn, int l15, int q4) {
          const int seg = nt >> 2;
          const float qs = (seg == 0) ? QSCALE : 1.f;
          const bool act = (seg == 3 || seg == 5);
#pragma unroll
          for (int i = 0; i < 8; ++i) {
            const int m = mt * 256 + wm * 128 + i * 16 + l15;
            const float rs = p.rstd[m] * qs;
            bf16_t* orow = p.proj + (size_t)m * DIN + nt * 256 + wn * 64 + 4 * q4;
            bf16_t* urow = p.mix + ((size_t)((m >> 13) * 64 + (nt - 16) * 16 + wn * 4) * SEQ + (m & (SEQ - 1))) * 16 + 4 * q4;
#pragma unroll
            for (int j = 0; j < 4; ++j) {
              float v0 = acc[i][j][0] * rs, v1 = acc[i][j][1] * rs, v2 = acc[i][j][2] * rs, v3 = acc[i][j][3] * rs;
              if (act) { v0 = silu_f(v0); v1 = silu_f(v1); v2 = silu_f(v2); v3 = silu_f(v3); }
              uint2 o; o.x = pk2(v0, v1); o.y = pk2(v2, v3);
              if (seg == 4) *(uint2*)(urow + (size_t)j * SEQ * 16) = o;
              else *(uint2*)(orow + j * 16) = o;
            }
          }
        };
        gemm_tile16(lds, wsb, DM / 64, la, lb, epi);
      }
    }
    xcd_barrier(xb);
    for (int rep = 0; rep < REP_P3; ++rep)
    for (int it = bid; it < 128 + 512; it += G) {
      if (it < 128) {
        const int g = 8 * (it & 7) + ((it >> 3) & 7), b = it >> 6, bg = b * 64 + g;
        const unsigned a0 = (unsigned)((const char*)(p.Wst + (size_t)(l * 64 + g) * 128 * 1024) - wsb);
        const unsigned u0 = (unsigned)((const char*)(p.mix + (size_t)bg * SEQ * 16) - wsb);
        auto la = [&](int row, int kc, int kt) { return a0 + (unsigned)((row * 1024 + kt * 64 + kc * 8) * 2); };
        auto lb = [&](int row, int kc, int kt) { return u0 + (unsigned)((row * 1024 + kt * 64 + kc * 8) * 2); };
        float* El = (float*)lds;
        auto epi = [&](f32x16 (&acc)[1][2], int wm, int wn, int l31, int h) {
          __syncthreads();
#pragma unroll
          for (int j = 0; j < 2; ++j)
#pragma unroll
              for (int r = 0; r < 16; ++r) {
                const int m = wm * 32 + crow(r, h), n = wn * 64 + j * 32 + l31;
                El[m * 129 + n] = acc[0][j][r];
              }
        };
        gemm_tile<4, 2, 1, false, 4>(lds, wsb, 16, la, lb, epi);
        __syncthreads();
        const int t2 = ltid();
        if (t2 < 64) {
          const int pp = t2;
          const float lr = p.lamL[((l * 64 + g) * 64 + pp) * 2], li = p.lamL[((l * 64 + g) * 64 + pp) * 2 + 1];
          bf16_t* Hb = p.Hb + (size_t)bg * 128 * 128;
          float hr = 0.f, hi = 0.f;
#pragma unroll 4
          for (int c = 0; c < 128; ++c) {
            Hb[c * 128 + pp] = f2bf(hr);
            Hb[c * 128 + 64 + pp] = f2bf(hi);
            const float er = El[pp * 129 + c], ei = El[(pp + 64) * 129 + c];
            const float n2 = lr * hr - li * hi + er;
            hi = lr * hi + li * hr + ei;
            hr = n2;
          }
        }
        __syncthreads();
      } else {
        attn_item(p, wsb, l, it - 128, lds);
      }
    }
    xcd_barrier(xb);
    for (int rep = 0; rep < REP_SSM; ++rep)
    for (int it = bid; it < 512; it += G) {
      const int jj = it & 255, yy = jj >> 3, g = 8 * (jj & 7) + (yy & 7), b = (yy >> 3) & 1, bg = b * 64 + g;
      const int k4 = ((yy >> 4) & 1) + 2 * (it >> 8), mt = (k4 < 2) ? k4 : 5 - k4;
      const int nkT = 4 * (mt + 1);
      const unsigned kc0 = (unsigned)((const char*)(p.Kc + (size_t)(l * 64 + g) * 16 * 64 * 16) - wsb);
      const unsigned wo0 = (unsigned)((const char*)(p.Wo + (size_t)(l * 64 + g) * 1024 * 128) - wsb);
      const unsigned u0 = (unsigned)((const char*)(p.mix + (size_t)bg * SEQ * 16) - wsb);
      const unsigned hb0 = (unsigned)((const char*)(p.Hb + (size_t)bg * 128 * 128) - wsb);
      const unsigned zero = (unsigned)((const char*)p.zero - wsb);
      auto la = [&](int row, int kc, int kt) -> unsigned {
        const int m = mt * 256 + row, t = m >> 4, co = m & 15;
        if (kt < nkT) {
          const int s = kt * 4 + (kc >> 1);
          return (s <= t) ? kc0 + (unsigned)(((co * 64 + (t - s)) * 16 + (kc & 1) * 8) * 2) : zero;
        }
        return wo0 + (unsigned)((m * 128 + (kt - nkT) * 64 + kc * 8) * 2);
      };
      auto lb = [&](int row, int kc, int kt) -> unsigned {
        if (kt < nkT) return u0 + (unsigned)((row * 1024 + kt * 64 + kc * 8) * 2);
        return hb0 + (unsigned)((row * 128 + (kt - nkT) * 64 + kc * 8) * 2);
      };
      auto epi = [&](f32x16 (&acc)[2][2], int wm, int wn, int l31, int h) {
#pragma unroll
        for (int i = 0; i < 2; ++i)
#pragma unroll
          for (int j = 0; j < 2; ++j) {
            const int c = wn * 64 + j * 32 + l31;
#pragma unroll
            for (int g4 = 0; g4 < 4; ++g4) {
              const int m = mt * 256 + wm * 64 + i * 32 + 8 * g4 + 4 * h;
              const int t = m >> 4, co = m & 15;
              const size_t tok = (size_t)b * SEQ + c * 64 + t;
              const int ch = g * 16 + co;
              const uint2 uu = *(const uint2*)(p.mix + ((size_t)bg * SEQ + c * 64 + t) * 16 + co);
              const f32x4 dd = *(const f32x4*)(p.ssm_d + l * 1024 + ch);
              const float y0 = acc[i][j][4 * g4 + 0] + dd[0] * __uint_as_float(uu.x << 16);
              const float y1 = acc[i][j][4 * g4 + 1] + dd[1] * __uint_as_float(uu.x & 0xffff0000u);
              const float y2 = acc[i][j][4 * g4 + 2] + dd[2] * __uint_as_float(uu.y << 16);
              const float y3 = acc[i][j][4 * g4 + 3] + dd[3] * __uint_as_float(uu.y & 0xffff0000u);
              uint2 o; o.x = pk2(gelu_tanh_f(y0), gelu_tanh_f(y1)); o.y = pk2(gelu_tanh_f(y2), gelu_tanh_f(y3));
              *(uint2*)(p.ybuf + tok * 1024 + ch) = o;
            }
          }
      };
      gemm_tile<4, 2, 2, false, 3>(lds, wsb, nkT + 2, la, lb, epi);
    }
    xcd_barrier(xb);
    {
      const bf16_t* Bt = p.wb_glu + (size_t)l * 2048 * 1024;
      for (int rep = 0; rep < REP_P56; ++rep)
      for (int it = bid; it < 64 * 8; it += G) {
        const int xx = it & 7, yy = (it >> 3) & 31, mt = 32 * (it >> 8) + 8 * (xx >> 1) + (yy & 7), nt = 4 * (xx & 1) + (yy >> 3);
        const unsigned a0 = (unsigned)((const char*)(p.ybuf + (size_t)mt * 256 * 1024) - wsb);
        const unsigned b0 = (unsigned)((const char*)(Bt + (size_t)nt * 256 * 1024) - wsb);
        auto la = [&](int row, int kc, int kt) { return a0 + (unsigned)((row * 1024 + kt * 64 + kc * 8) * 2); };
        auto lb = [&](int row, int kc, int kt) { return b0 + (unsigned)((row * 1024 + kt * 64 + kc * 8) * 2); };
        auto epi = [&](f32x4v (&acc)[8][4], int wm, int wn, int l15, int q4) {
          const int jj = (nt * 4 + wn) * 32 + 4 * q4;
#pragma unroll
          for (int i = 0; i < 8; ++i) {
            const size_t m = (size_t)mt * 256 + wm * 128 + i * 16 + l15;
            const bf16_t* zrow = p.proj + m * DIN + 5120 + jj;
            bf16_t* orow = p.mixin + m * DM + 1024 + jj;
#pragma unroll
            for (int j = 0; j < 2; ++j) {
              const uint2 z = *(const uint2*)(zrow + 16 * j);
              const float v0 = acc[i][j][0] * sigmoid_f(acc[i][j + 2][0]) * __uint_as_float(z.x << 16);
              const float v1 = acc[i][j][1] * sigmoid_f(acc[i][j + 2][1]) * __uint_as_float(z.x & 0xffff0000u);
              const float v2 = acc[i][j][2] * sigmoid_f(acc[i][j + 2][2]) * __uint_as_float(z.y << 16);
              const float v3 = acc[i][j][3] * sigmoid_f(acc[i][j + 2][3]) * __uint_as_float(z.y & 0xffff0000u);
              uint2 o; o.x = pk2(v0, v1); o.y = pk2(v2, v3);
              *(uint2*)(orow + 16 * j) = o;
            }
          }
        };
        gemm_tile16(lds, wsb, 16, la, lb, epi);
      }
    }
    xcd_barrier(xb);
    {
      const bf16_t* Bt = p.wb_out + (size_t)l * DM * DM;
      for (int rep = 0; rep < REP_P56; ++rep)
      for (int it = bid; it < 64 * 8; it += G) {
        const int xx = it & 7, yy = (it >> 3) & 31, mt = 32 * (it >> 8) + 8 * (xx >> 1) + (yy & 7), nt = 4 * (xx & 1) + (yy >> 3);
        const unsigned a0 = (unsigned)((const char*)(p.mixin + (size_t)mt * 256 * DM) - wsb);
        const unsigned b0 = (unsigned)((const char*)(Bt + (size_t)nt * 256 * DM) - wsb);
        auto la = [&](int row, int kc, int kt) { return a0 + (unsigned)((row * DM + kt * 64 + kc * 8) * 2); };
        auto lb = [&](int row, int kc, int kt) { return b0 + (unsigned)((row * DM + kt * 64 + kc * 8) * 2); };
        auto epi = [&](f32x4v (&acc)[8][4], int wm, int wn, int l15, int q4) {
#pragma unroll
          for (int i = 0; i < 8; ++i) {
            const size_t m = (size_t)mt * 256 + wm * 128 + i * 16 + l15;
            bf16_t* orow = p.mix + m * DM + nt * 256 + wn * 64 + 4 * q4;
#pragma unroll
            for (int j = 0; j < 4; ++j) {
              uint2 o; o.x = pk2(acc[i][j][0], acc[i][j][1]); o.y = pk2(acc[i][j][2], acc[i][j][3]);
              *(uint2*)(orow + j * 16) = o;
            }
          }
        };
        gemm_tile16(lds, wsb, DM / 64, la, lb, epi);
      }
    }
    xcd_barrier(xb);
    for (int it = bid; it < NTOK / 8; it += G) resid_row(p, l, it * 8 + (ltid() >> 6));
    xcd_barrier(xb);
  }
}

extern "C" void kernel_launch(void* const* d_in, const int* in_sizes, int n_in, void* d_out, int out_size, void* d_ws,
                              size_t ws_size, hipStream_t stream) {
  static int grid_blocks = 0;
  if (!grid_blocks) {
    int dev = 0, cus = 0, per_cu = 0;
    hipGetDevice(&dev);
    hipDeviceGetAttribute(&cus, hipDeviceAttributeMultiprocessorCount, dev);
    hipOccupancyMaxActiveBlocksPerMultiprocessor(&per_cu, mega, NTHR, 0);
    if (per_cu < 1) per_cu = 1;
    if (per_cu > 1) per_cu = 1;
    grid_blocks = cus * per_cu;
  }
  Params p{};
  p.x = (const float*)d_in[0]; p.rel_bias = (const float*)d_in[1]; p.pre_g = (const float*)d_in[2]; p.post_g = (const float*)d_in[3];
  p.w_in = (const float*)d_in[4]; p.lq1 = (const float*)d_in[5]; p.lk1 = (const float*)d_in[6]; p.lq2 = (const float*)d_in[7];
  p.lk2 = (const float*)d_in[8]; p.subln_g = (const float*)d_in[9]; p.a_re = (const float*)d_in[10]; p.a_im = (const float*)d_in[11];
  p.log_dt = (const float*)d_in[12]; p.b_re = (const float*)d_in[13]; p.b_im = (const float*)d_in[14]; p.c_re = (const float*)d_in[15];
  p.c_im = (const float*)d_in[16]; p.ssm_d = (const float*)d_in[17]; p.w_glu = (const float*)d_in[18]; p.w_out = (const float*)d_in[19];
  p.out = (float*)d_out;
  char* ws = (char*)d_ws;
  size_t off = 0;
  auto take = [&](size_t bytes) { char* r = ws + off; off += (bytes + 255) & ~(size_t)255; return r; };
  p.wb_in = (bf16_t*)take((size_t)4 * DIN * DM * 2);
  p.wb_glu = (bf16_t*)take((size_t)4 * 2048 * 1024 * 2);
  p.wb_out = (bf16_t*)take((size_t)4 * DM * DM * 2);
  p.proj = (bf16_t*)take((size_t)NTOK * DIN * 2);
  p.mixin = (bf16_t*)take((size_t)NTOK * DM * 2);
  p.ybuf = (bf16_t*)take((size_t)NTOK * 1024 * 2);
  p.mix = (bf16_t*)take((size_t)NTOK * DM * 2);
  p.xb = (bf16_t*)take((size_t)NTOK * DM * 2);
  p.Kc = (bf16_t*)take((size_t)4 * 64 * 16 * 64 * 16 * 2);
  p.Wst = (bf16_t*)take((size_t)4 * 64 * 128 * 1024 * 2);
  p.Wo = (bf16_t*)take((size_t)4 * 64 * 1024 * 128 * 2);
  p.Hb = (bf16_t*)take((size_t)128 * 128 * 128 * 2);
  p.rstd = (float*)take((size_t)NTOK * 4);
  p.lam = (float*)take(256);
  p.E = nullptr;
  p.xlo = (bf16_t*)take((size_t)NTOK * DM * 2);
  p.lamL = (float*)take((size_t)4 * 64 * 64 * 2 * 4);
  p.zero = (float*)take(256);
  p.bar = (unsigned*)take(XCD_BAR_WORDS * 4);
  p.use_cg = 0ull;
  if (off > ws_size) { fprintf(stderr, "workspace too small: need %zu have %zu\n", off, ws_size); return; }
  (void)hipMemsetAsync(p.bar, 0, XCD_BAR_WORDS * 4, stream);
  void* args[] = {&p};
  hipError_t e = hipLaunchCooperativeKernel((void*)mega, dim3(grid_blocks), dim3(NTHR), args, 0, stream);
  if (e != hipSuccess) fprintf(stderr, "cooperative launch failed: %s (grid %d)\n", hipGetErrorString(e), grid_blocks);
}
```

```cpp
#include <hip/hip_runtime.h>
#include <hip/hip_cooperative_groups.h>
#include <cstdio>
#include <cstdint>
#include <type_traits>
namespace cg = cooperative_groups;

#define DI __device__ __forceinline__
typedef unsigned short bf16_t;
typedef short bf16x8 __attribute__((ext_vector_type(8)));
typedef short s16x4 __attribute__((ext_vector_type(4)));
typedef float f32x16 __attribute__((ext_vector_type(16)));
typedef float f32x4 __attribute__((ext_vector_type(4)));
typedef float f32x2 __attribute__((ext_vector_type(2)));
typedef __bf16 bf2_t __attribute__((ext_vector_type(2)));
typedef __attribute__((address_space(3))) s16x4 lds_s16x4;
typedef __attribute__((address_space(3))) void lds_void;

constexpr int REP_P1 = 1, REP_P3 = 1, REP_SSM = 1, REP_P56 = 1;
constexpr int SEQ = 8192, NTOK = 16384, DM = 2048, DIN = 6144;
constexpr float LOG2E = 1.4426950408889634f;
constexpr float QSCALE = 0.125f * LOG2E;
constexpr int NTHR = 512;
constexpr int LDS_BYTES = 148752;
constexpr int XBW_OFF = 148736;
constexpr int ATT_STAGE = 32768;
constexpr int ATT_VOFF = 16384;
constexpr int BT_OFF = 147456;

struct Params {
  const float *x, *rel_bias, *pre_g, *post_g, *w_in, *lq1, *lk1, *lq2, *lk2, *subln_g, *a_re, *a_im, *log_dt,
      *b_re, *b_im, *c_re, *c_im, *ssm_d, *w_glu, *w_out;
  float* out;
  bf16_t *wb_in, *wb_glu, *wb_out, *proj, *mixin, *ybuf, *mix, *xb, *xlo, *Kc, *Wst, *Wo, *Hb;
  float *rstd, *lam, *E, *lamL, *zero;
  unsigned* bar;
  unsigned long long use_cg;
};

DI int ltid() { int t = threadIdx.x; asm volatile("" : "+v"(t)); return t; }
DI int crow(int r, int h) { return (r & 3) + 8 * (r >> 2) + 4 * h; }
DI float bf2f(bf16_t u) { return __uint_as_float(((unsigned)u) << 16); }
DI unsigned pk2(float a, float b) { f32x2 v = {a, b}; bf2_t r = __builtin_convertvector(v, bf2_t); return __builtin_bit_cast(unsigned, r); }
DI bf16_t f2bf(float a) { return (bf16_t)(pk2(a, 0.f) & 0xffffu); }
DI float wave_sum(float v) {
#pragma unroll
  for (int o = 32; o >= 1; o >>= 1) v += __shfl_xor(v, o);
  return v;
}
DI float silu_f(float v) { return v * __builtin_amdgcn_rcpf(1.f + __expf(-v)); }
DI float sigmoid_f(float v) { return __builtin_amdgcn_rcpf(1.f + __expf(-v)); }
DI float gelu_tanh_f(float v) { const float u = 1.5957691216057308f * (v + 0.044715f * v * v * v); return v * __builtin_amdgcn_rcpf(1.f + __expf(-u)); }
DI f32x16 mfma32(bf16x8 a, bf16x8 b, f32x16 c) { return __builtin_amdgcn_mfma_f32_32x32x16_bf16(a, b, c, 0, 0, 0); }
DI s16x4 tr_read(const char* p) { return __builtin_amdgcn_ds_read_tr16_b64_v4i16((lds_s16x4*)p); }


#define XB_TMO      128
#define XB_XCNT(j)  (256  + 64 * (j))
#define XB_XSUB(j)  (1280 + 64 * (j))
#define XB_XGEN(j)  (2304 + 64 * (j))
#define XB_TOP      3328
#define XB_TOPGEN   3392
#define XCD_BAR_WORDS 3456
#define XB_SPIN_CAP (1u << 22)
#define LAS __attribute__((address_space(3)))
DI unsigned xb_ld(unsigned* p) { return __hip_atomic_load(p, __ATOMIC_RELAXED, __HIP_MEMORY_SCOPE_AGENT); }
DI unsigned xb_add(unsigned* p, unsigned v) { return __hip_atomic_fetch_add(p, v, __ATOMIC_RELAXED, __HIP_MEMORY_SCOPE_AGENT); }
DI unsigned xb_xcc_id() { return (unsigned)__builtin_amdgcn_s_getreg((3 << 11) | 20) & 0xFu; }
#define XB_SPIN(cond, bar) do { unsigned _sp = 0; while (cond) { __builtin_amdgcn_s_sleep(1); \
    if ((++_sp & 255u) == 0u) { if (xb_ld(&(bar)[XB_TMO])) break; if (_sp > XB_SPIN_CAP) { atomicAdd(&(bar)[XB_TMO], 1u); break; } } } } while (0)
struct XcdBarrier { unsigned* bar; unsigned x; volatile LAS unsigned* st; };
DI XcdBarrier xcd_barrier_post(unsigned* bar, volatile LAS unsigned* st) {
  XcdBarrier b; b.bar = bar; b.x = xb_xcc_id(); b.st = st;
  if (threadIdx.x == 0) (void)xb_add(&bar[XB_XCNT(b.x)], 1u);
  return b;
}
DI void xcd_barrier_complete(unsigned* bar, unsigned x, unsigned& nloc, unsigned& nx) {
  const unsigned G = gridDim.x * gridDim.y * gridDim.z;
  unsigned sum, cnt, mine, sp = 0u;
  for (;;) {
    sum = 0u; cnt = 0u; mine = 0u;
#pragma unroll
    for (unsigned j = 0; j < 16; ++j) { const unsigned c = xb_ld(&bar[XB_XCNT(j)]); sum += c; cnt += (c > 0u) ? 1u : 0u; mine = (j == x) ? c : mine; }
    if (sum == G) break;
    __builtin_amdgcn_s_sleep(1);
    if ((++sp & 255u) == 0u) { if (xb_ld(&bar[XB_TMO])) break; if (sp > XB_SPIN_CAP) { atomicAdd(&bar[XB_TMO], 1u); break; } }
  }
  nloc = mine > 0u ? mine : 1u; nx = cnt > 0u ? cnt : 1u;
}
DI void xcd_barrier(const XcdBarrier& b) {
  asm volatile("s_waitcnt vmcnt(0)" ::: "memory");
  __syncthreads();
  if (threadIdx.x == 0) {
    unsigned* bar = b.bar;
    unsigned bx = b.x; asm volatile("" : "+s"(bx));
    __builtin_amdgcn_s_waitcnt(0);
    unsigned nloc = b.st[0], nx = b.st[1];
    if (nloc == 0u) { xcd_barrier_complete(bar, bx, nloc, nx); b.st[0] = nloc; b.st[1] = nx; }
    const unsigned old = xb_add(&bar[XB_XSUB(bx)], 1u);
    const unsigned gen = old / nloc;
    if (old + 1u == (gen + 1u) * nloc) {
      __builtin_amdgcn_fence(__ATOMIC_RELEASE, "agent");
      asm volatile("s_waitcnt vmcnt(0)" ::: "memory");
      const unsigned og = xb_add(&bar[XB_TOP], 1u);
      const unsigned tg = og / nx;
      if (og + 1u == (tg + 1u) * nx) xb_add(&bar[XB_TOPGEN], 1u);
      else XB_SPIN(xb_ld(&bar[XB_TOPGEN]) == tg, bar);
      __builtin_amdgcn_fence(__ATOMIC_ACQUIRE, "agent");
      xb_add(&bar[XB_XGEN(bx)], 1u);
      asm volatile("s_waitcnt vmcnt(0)" ::: "memory");
    } else {
      XB_SPIN(xb_ld(&bar[XB_XGEN(bx)]) == gen, bar);
      __builtin_amdgcn_fence(__ATOMIC_ACQUIRE, "agent");
      asm volatile("s_waitcnt vmcnt(0)" ::: "memory");
    }
  }
  __syncthreads();
}

template <int WM, int WN, int MT, bool TR, int NSTG, class LA, class LB, class EPI>
DI void gemm_tile(char* lds, const char* gbase, int nk, LA la, LB lb, EPI epi) {
  static_assert(WM * WN == 8, "8 waves");
  static_assert(NSTG == 3 || NSTG == 4, "stages");
  constexpr int BM = WM * 32 * MT, BN = WN * 64, NA = BM / 64, NB = BN / 64, NL = NA + NB, BOFF = BM * 128, STG = BOFF + BN * 128;
  static_assert(NSTG * STG <= 147456, "LDS stage area");
  int tid_ = threadIdx.x; asm volatile("" : "+v"(tid_));
  const int tid = tid_, lane = tid & 63, wave = tid >> 6, wm = wave / WN, wn = wave % WN;
  const int l31 = lane & 31, h = lane >> 5;
  const int lr = lane >> 3, gch = lane & 7;
  f32x16 acc[MT][2];
#pragma unroll
  for (int i = 0; i < MT; ++i)
#pragma unroll
    for (int j = 0; j < 2; ++j)
#pragma unroll
      for (int r = 0; r < 16; ++r) acc[i][j][r] = 0.f;
  const __amdgpu_buffer_rsrc_t rsrc = __builtin_amdgcn_make_buffer_rsrc((void*)gbase, (short)0, 0x7fffffff, 0x00020000);
  auto piece = [&](int kt, int st, int i) {
    char* base = lds + st * STG;
    if (i < NA) {
      const int row = 8 * (wave * NA + i) + lr;
      const int c = gch ^ ((row >> 1) & 7);
      __builtin_amdgcn_raw_ptr_buffer_load_lds(rsrc, (lds_void*)(base + (wave * NA + i) * 1024), 16, la(row, c, kt), 0, 0, 0);
    } else {
      const int i2 = i - NA;
      const int row = 8 * (wave * NB + i2) + lr;
      const int c = gch ^ ((row >> 1) & 7);
      __builtin_amdgcn_raw_ptr_buffer_load_lds(rsrc, (lds_void*)(base + BOFF + (wave * NB + i2) * 1024), 16, lb(row, c, kt), 0, 0, 0);
    }
  };
  const int xs = (l31 >> 1) & 7;
  const int arow = (wm * 32 * MT + l31) * 128, brow = BOFF + (wn * 64 + l31) * 128;
#pragma unroll
  for (int t = 0; t < NSTG - 1; ++t)
    if (t < nk) {
#pragma unroll
      for (int i = 0; i < NL; ++i) piece(t, t, i);
    }
  auto rd = [&](const char* a, int s, bf16x8 (&af)[MT], bf16x8 (&bf)[2]) {
    const int co = 16 * ((2 * s + h) ^ xs);
#pragma unroll
    for (int j = 0; j < 2; ++j) bf[j] = *(const bf16x8*)(a + brow + j * 4096 + co);
#pragma unroll
    for (int i = 0; i < MT; ++i) af[i] = *(const bf16x8*)(a + arow + i * 4096 + co);
  };
  int sc = 0;
#pragma unroll 1
  for (int kt = 0; kt < nk; ++kt) {
    if (NSTG >= 4 && kt + 2 < nk) asm volatile("s_waitcnt vmcnt(%0)" ::"n"(2 * NL) : "memory");
    else if (kt + 1 < nk) asm volatile("s_waitcnt vmcnt(%0)" ::"n"(NL) : "memory");
    else asm volatile("s_waitcnt vmcnt(0)" ::: "memory");
    __builtin_amdgcn_s_barrier();
    asm volatile("" ::: "memory");
    const bool more = (kt + NSTG - 1 < nk);
    const int sf = (sc == 0) ? NSTG - 1 : sc - 1;
    const char* a0 = lds + sc * STG;
    bf16x8 af0[MT], af1[MT], bf0[2], bf1[2];
    rd(a0, 0, af0, bf0);
    rd(a0, 1, af1, bf1);
    __builtin_amdgcn_sched_barrier(0);
#pragma unroll
    for (int s = 0; s < 4; ++s) {
      bf16x8 (&af)[MT] = (s & 1) ? af1 : af0;
      bf16x8 (&bf)[2] = (s & 1) ? bf1 : bf0;
#pragma unroll
      for (int i = 0; i < MT; ++i) {
        acc[i][0] = TR ? mfma32(bf[0], af[i], acc[i][0]) : mfma32(af[i], bf[0], acc[i][0]);
        acc[i][1] = TR ? mfma32(bf[1], af[i], acc[i][1]) : mfma32(af[i], bf[1], acc[i][1]);
        if (s < 2) {
          __builtin_amdgcn_sched_barrier(0);
          const int pi = s * MT + i;
          if (pi < NL) { if (more) piece(kt + NSTG - 1, sf, pi); }
          __builtin_amdgcn_sched_barrier(0);
        }
      }
      if (s == 1) {
#pragma unroll
        for (int pi = 2 * MT; pi < NL; ++pi) { if (more) piece(kt + NSTG - 1, sf, pi); }
      }
      __builtin_amdgcn_sched_barrier(0);
      if (s < 2) { rd(a0, s + 2, af, bf); __builtin_amdgcn_sched_barrier(0); }
    }
    sc = (sc == NSTG - 1) ? 0 : sc + 1;
  }
  epi(acc, wm, wn, l31, h);
  __syncthreads();
}

typedef float f32x4v __attribute__((ext_vector_type(4)));
DI f32x4v mfma16(bf16x8 a, bf16x8 b, f32x4v c) { return __builtin_amdgcn_mfma_f32_16x16x32_bf16(a, b, c, 0, 0, 0); }
template <class LA, class LB, class EPI>
DI void gemm_tile16(char* lds, const char* gbase, int nk, LA la, LB lb, EPI epi) {
  constexpr int STG = 65536, BOFF = 32768, NL = 8;
  int tid_ = threadIdx.x; asm volatile("" : "+v"(tid_));
  const int tid = tid_, lane = tid & 63, wave = tid >> 6, wm = wave >> 2, wn = wave & 3;
  const int l15 = lane & 15, q4 = lane >> 4;
  const int lr = lane >> 3, gch = lane & 7;
  f32x4v acc[8][4];
#pragma unroll
  for (int i = 0; i < 8; ++i)
#pragma unroll
    for (int j = 0; j < 4; ++j)
#pragma unroll
      for (int e = 0; e < 4; ++e) acc[i][j][e] = 0.f;
  const __amdgpu_buffer_rsrc_t rsrc = __builtin_amdgcn_make_buffer_rsrc((void*)gbase, (short)0, 0x7fffffff, 0x00020000);
  auto piece = [&](int kt, int i) {
    char* base = lds + (kt & 1) * STG;
    if (i < 4) {
      const int row = 8 * (wave * 4 + i) + lr;
      const int c = gch ^ ((row >> 1) & 7);
      __builtin_amdgcn_raw_ptr_buffer_load_lds(rsrc, (lds_void*)(base + (wave * 4 + i) * 1024), 16, la(row, c, kt), 0, 0, 0);
    } else {
      const int i2 = i - 4;
      const int row = 8 * (wave * 4 + i2) + lr;
      const int c = gch ^ ((row >> 1) & 7);
      __builtin_amdgcn_raw_ptr_buffer_load_lds(rsrc, (lds_void*)(base + BOFF + (wave * 4 + i2) * 1024), 16, lb(row, c, kt), 0, 0, 0);
    }
  };
  const int xs = (l15 >> 1) & 7;
  const int arow = (wm * 128 + l15) * 128, brow = BOFF + (wn * 64 + l15) * 128;
  const int co0 = 16 * (q4 ^ xs), co1 = 16 * ((4 + q4) ^ xs);
#pragma unroll
  for (int i = 0; i < NL; ++i) piece(0, i);
  auto rdB = [&](const char* a, int co, bf16x8 (&bf)[4]) {
#pragma unroll
    for (int j = 0; j < 4; ++j) bf[j] = *(const bf16x8*)(a + brow + j * 2048 + co);
  };
  auto rdA = [&](const char* a, int co, int half, bf16x8 (&af)[4]) {
#pragma unroll
    for (int i = 0; i < 4; ++i) af[i] = *(const bf16x8*)(a + arow + (half * 4 + i) * 2048 + co);
  };
#pragma unroll 1
  for (int kt = 0; kt < nk; ++kt) {
    asm volatile("s_waitcnt vmcnt(0)" ::: "memory");
    __builtin_amdgcn_s_barrier();
    asm volatile("" ::: "memory");
    const bool more = (kt + 1 < nk);
    const char* a0 = lds + (kt & 1) * STG;
    bf16x8 B0[4], B1[4], Alo[4], Ahi[4];
    Alo[0] = *(const bf16x8*)(a0 + arow + co0);
    rdB(a0, co0, B0);
#pragma unroll
    for (int i = 1; i < 4; ++i) Alo[i] = *(const bf16x8*)(a0 + arow + i * 2048 + co0);
    rdA(a0, co0, 1, Ahi);
    __builtin_amdgcn_sched_barrier(0);
#pragma unroll
    for (int i = 0; i < 4; ++i) {
#pragma unroll
      for (int j = 0; j < 4; ++j) acc[i][j] = mfma16(B0[j], Alo[i], acc[i][j]);
      __builtin_amdgcn_sched_barrier(0);
      if (more) piece(kt + 1, i);
      __builtin_amdgcn_sched_barrier(0);
    }
    rdB(a0, co1, B1);
    rdA(a0, co1, 0, Alo);
    __builtin_amdgcn_sched_barrier(0);
#pragma unroll
    for (int i = 0; i < 4; ++i) {
#pragma unroll
      for (int j = 0; j < 4; ++j) acc[4 + i][j] = mfma16(B0[j], Ahi[i], acc[4 + i][j]);
      __builtin_amdgcn_sched_barrier(0);
      if (more) piece(kt + 1, 4 + i);
      __builtin_amdgcn_sched_barrier(0);
    }
    rdA(a0, co1, 1, Ahi);
    __builtin_amdgcn_sched_barrier(0);
#pragma unroll
    for (int i = 0; i < 4; ++i)
#pragma unroll
      for (int j = 0; j < 4; ++j) acc[i][j] = mfma16(B1[j], Alo[i], acc[i][j]);
    __builtin_amdgcn_sched_barrier(0);
#pragma unroll
    for (int i = 0; i < 4; ++i)
#pragma unroll
      for (int j = 0; j < 4; ++j) acc[4 + i][j] = mfma16(B1[j], Ahi[i], acc[4 + i][j]);
  }
  epi(acc, wm, wn, l15, q4);
  __syncthreads();
}

DI void wconv_item(const float* __restrict__ src, int K, int N, bf16_t* __restrict__ dst, const float* __restrict__ gain,
                   int glu_perm, int kt, int ng, char* lds) {
  float* tile = (float*)lds;
  int tid_ = threadIdx.x; asm volatile("" : "+v"(tid_));
  const int tid = tid_;
  __syncthreads();
  f32x4 v[8];
#pragma unroll
  for (int i = 0; i < 8; ++i) {
    const int kk = i * 8 + (tid >> 6), n4 = (tid & 63) * 4;
    const int np = ng * 256 + n4;
    int sc = np;
    if (glu_perm) { const int blk = np >> 6, w = np & 63; const int j = blk * 32 + (w & 31); sc = (w < 32) ? j : 1024 + j; }
    v[i] = *(const f32x4*)(src + (size_t)(kt * 64 + kk) * N + sc);
  }
#pragma unroll
  for (int i = 0; i < 8; ++i) {
    const int kk = i * 8 + (tid >> 6), n4 = (tid & 63) * 4;
    if (gain) { const float gg = gain[kt * 64 + kk]; v[i][0] *= gg; v[i][1] *= gg; v[i][2] *= gg; v[i][3] *= gg; }
    *(f32x4*)(tile + kk * 260 + n4) = v[i];
  }
  __syncthreads();
#pragma unroll
  for (int i = 0; i < 4; ++i) {
    const int nn = (tid & 63) + 64 * (i & 3), kc = tid >> 6;
    uint4 w;
    w.x = pk2(tile[(kc * 8 + 0) * 260 + nn], tile[(kc * 8 + 1) * 260 + nn]);
    w.y = pk2(tile[(kc * 8 + 2) * 260 + nn], tile[(kc * 8 + 3) * 260 + nn]);
    w.z = pk2(tile[(kc * 8 + 4) * 260 + nn], tile[(kc * 8 + 5) * 260 + nn]);
    w.w = pk2(tile[(kc * 8 + 6) * 260 + nn], tile[(kc * 8 + 7) * 260 + nn]);
    *(uint4*)(dst + (size_t)(ng * 256 + nn) * K + kt * 64 + kc * 8) = w;
  }
}

DI void xprep_row(const float* __restrict__ x, int row, bf16_t* __restrict__ xb, float* __restrict__ rstd) {
  const int lane = ltid() & 63;
  const float* src = x + (size_t)row * DM;
  float ss = 0.f;
#pragma unroll
  for (int i = 0; i < 4; ++i) {
    const int c = lane * 8 + 512 * i;
    const f32x4 a = *(const f32x4*)(src + c), b = *(const f32x4*)(src + c + 4);
    ss += a[0] * a[0] + a[1] * a[1] + a[2] * a[2] + a[3] * a[3] + b[0] * b[0] + b[1] * b[1] + b[2] * b[2] + b[3] * b[3];
    uint4 w; w.x = pk2(a[0], a[1]); w.y = pk2(a[2], a[3]); w.z = pk2(b[0], b[1]); w.w = pk2(b[2], b[3]);
    *(uint4*)(xb + (size_t)row * DM + c) = w;
  }
  ss = wave_sum(ss);
  if (lane == 0) rstd[row] = rsqrtf(ss * (1.f / DM) + 1e-6f);
}

DI void ssm_prep_item(const Params& p, int l, int g, char* lds) {
  float* pwre = (float*)lds;
  float* pwim = pwre + 65 * 65;
  float* Bre = pwim + 65 * 65;
  float* Bim = Bre + 1024;
  float* Cre = Bim + 1024;
  float* Cim = Cre + 1040;
  float* cfre = Cim + 1040;
  float* cfim = cfre + 64;
  int tid_ = threadIdx.x; asm volatile("" : "+v"(tid_));
  const int tid = tid_;
  const int lg = l * 64 + g;
  __syncthreads();
  if (tid < 64) {
    const int pp = tid;
    const double dt = exp((double)p.log_dt[lg]);
    const double ar = p.a_re[lg * 64 + pp], ai = p.a_im[lg * 64 + pp];
    const double mag = exp(dt * ar), lr = mag * cos(dt * ai), li = mag * sin(dt * ai);
    const double den = ar * ar + ai * ai, nr = lr - 1.0;
    cfre[pp] = (float)((nr * ar + li * ai) / den);
    cfim[pp] = (float)((li * ar - nr * ai) / den);
    double wr = 1.0, wi = 0.0;
#pragma unroll 1
    for (int t = 0; t <= 64; ++t) {
      pwre[t * 65 + pp] = (float)wr; pwim[t * 65 + pp] = (float)wi;
      const double n2 = wr * lr - wi * li; wi = wr * li + wi * lr; wr = n2;
    }
    p.lamL[(lg * 64 + pp) * 2] = pwre[64 * 65 + pp];
    p.lamL[(lg * 64 + pp) * 2 + 1] = pwim[64 * 65 + pp];
  }
  for (int e = tid; e < 1024; e += NTHR) { Cre[(e >> 6) * 65 + (e & 63)] = p.c_re[lg * 1024 + e]; Cim[(e >> 6) * 65 + (e & 63)] = p.c_im[lg * 1024 + e]; }
  if (l == 0 && g == 0 && tid < 64) p.zero[tid] = 0.f;
  if (g == 0 && tid == 0) {
    float s1 = 0.f, s2 = 0.f;
    for (int i = 0; i < 64; ++i) { s1 += p.lq1[l * 64 + i] * p.lk1[l * 64 + i]; s2 += p.lq2[l * 64 + i] * p.lk2[l * 64 + i]; }
    const float lam_init = 0.8f - 0.6f * expf(-0.3f * (float)l);
    p.lam[l] = expf(s1) - expf(s2) + lam_init;
  }
  __syncthreads();
  for (int e = tid; e < 1024; e += NTHR) {
    const int pp = e >> 4;
    const float br = p.b_re[lg * 1024 + e], bi = p.b_im[lg * 1024 + e];
    Bre[e] = cfre[pp] * br - cfim[pp] * bi;
    Bim[e] = cfre[pp] * bi + cfim[pp] * br;
  }
  __syncthreads();
#pragma unroll 1
  for (int q = 0; q < 2; ++q) {
    const int idx = tid + NTHR * q, co = idx >> 6, tau = idx & 63;
    float acc[16];
#pragma unroll
    for (int c = 0; c < 16; ++c) acc[c] = 0.f;
#pragma unroll 2
    for (int pp = 0; pp < 64; ++pp) {
      const float cr = Cre[co * 65 + pp], ci = Cim[co * 65 + pp], wr = pwre[tau * 65 + pp], wi = pwim[tau * 65 + pp];
      const float xr = cr * wr - ci * wi, xi = cr * wi + ci * wr;
#pragma unroll
      for (int c = 0; c < 16; ++c) acc[c] += xr * Bre[pp * 16 + c] - xi * Bim[pp * 16 + c];
    }
    uint4 w0, w1;
    w0.x = pk2(acc[0], acc[1]); w0.y = pk2(acc[2], acc[3]); w0.z = pk2(acc[4], acc[5]); w0.w = pk2(acc[6], acc[7]);
    w1.x = pk2(acc[8], acc[9]); w1.y = pk2(acc[10], acc[11]); w1.z = pk2(acc[12], acc[13]); w1.w = pk2(acc[14], acc[15]);
    bf16_t* d = p.Kc + ((size_t)(lg * 16 + co) * 64 + tau) * 16;
    *(uint4*)d = w0; *(uint4*)(d + 8) = w1;
  }
#pragma unroll 1
  for (int q = 0; q < 16; ++q) {
    const int idx = tid + NTHR * q, pr = idx >> 6, s = idx & 63, pp = pr & 63;
    const float wr = pwre[(63 - s) * 65 + pp], wi = pwim[(63 - s) * 65 + pp];
    float v[16];
#pragma unroll
    for (int c = 0; c < 16; ++c) {
      const float br = Bre[pp * 16 + c], bi = Bim[pp * 16 + c];
      v[c] = (pr < 64) ? (wr * br - wi * bi) : (wr * bi + wi * br);
    }
    uint4 w0, w1;
    w0.x = pk2(v[0], v[1]); w0.y = pk2(v[2], v[3]); w0.z = pk2(v[4], v[5]); w0.w = pk2(v[6], v[7]);
    w1.x = pk2(v[8], v[9]); w1.y = pk2(v[10], v[11]); w1.z = pk2(v[12], v[13]); w1.w = pk2(v[14], v[15]);
    bf16_t* d = p.Wst + ((size_t)(lg * 128 + pr)) * 1024 + s * 16;
    *(uint4*)d = w0; *(uint4*)(d + 8) = w1;
  }
#pragma unroll 1
  for (int q = 0; q < 32; ++q) {
    const int idx = tid + NTHR * q, m = idx >> 4, ch = idx & 15, t = m >> 4, co = m & 15;
    float v[8];
#pragma unroll
    for (int j = 0; j < 8; ++j) {
      const int pr = ch * 8 + j, pp = pr & 63;
      const float cr = Cre[co * 65 + pp], ci = Cim[co * 65 + pp], wr = pwre[(t + 1) * 65 + pp], wi = pwim[(t + 1) * 65 + pp];
      v[j] = (pr < 64) ? (cr * wr - ci * wi) : -(cr * wi + ci * wr);
    }
    uint4 w0;
    w0.x = pk2(v[0], v[1]); w0.y = pk2(v[2], v[3]); w0.z = pk2(v[4], v[5]); w0.w = pk2(v[6], v[7]);
    *(uint4*)(p.Wo + ((size_t)(lg * 1024 + m)) * 128 + ch * 8) = w0;
  }
}

typedef unsigned u32x4 __attribute__((ext_vector_type(4)));

DI bf16x8 v_frag(const char* a0, const char* a1) {
  const s16x4 lo = tr_read(a0);
  const s16x4 hi = tr_read(a1);
  return __builtin_shufflevector(lo, hi, 0, 1, 2, 3, 4, 5, 6, 7);
}

template <bool NEAR>
DI void attn_tile(const char* kb, const bf16x8 (&q)[4], f32x16 (&O)[4], float& mrun, float& lsum,
                  const float* btab, int relb, float cfar, int ko0, int ko1, int ko2, int ko3, int vA0, int vA1, bool first, f32x16& I) {
  f32x16 S0, S1;
  auto comp_s = [&]() {
    const bf16x8 k00 = *(const bf16x8*)(kb + ko0), k10 = *(const bf16x8*)(kb + ko0 + 8192);
    const bf16x8 k01 = *(const bf16x8*)(kb + ko1), k11 = *(const bf16x8*)(kb + ko1 + 8192);
    const bf16x8 k02 = *(const bf16x8*)(kb + ko2), k12 = *(const bf16x8*)(kb + ko2 + 8192);
    const bf16x8 k03 = *(const bf16x8*)(kb + ko3), k13 = *(const bf16x8*)(kb + ko3 + 8192);
    __builtin_amdgcn_sched_barrier(0);
    S0 = mfma32(k00, q[0], I); S1 = mfma32(k10, q[0], I);
    S0 = mfma32(k01, q[1], S0); S1 = mfma32(k11, q[1], S1);
    S0 = mfma32(k02, q[2], S0); S1 = mfma32(k12, q[2], S1);
    S0 = mfma32(k03, q[3], S0); S1 = mfma32(k13, q[3], S1);
    if (NEAR) {
#pragma unroll
      for (int r = 0; r < 16; ++r) {
        S0[r] += btab[relb + (r & 3) + 8 * (r >> 2)];
        S1[r] += btab[relb + 32 + (r & 3) + 8 * (r >> 2)];
      }
    }
  };
  comp_s();
  const char* vb = kb + ATT_VOFF;
  bool need = first;
  float ps = 0.f;
  if (!first) {
#pragma unroll
    for (int r = 0; r < 16; ++r) {
      S0[r] = __builtin_amdgcn_exp2f(S0[r]); S1[r] = __builtin_amdgcn_exp2f(S1[r]);
      ps += S0[r];
      ps += S1[r];
    }
    need = __any(!(ps <= 1048576.f));
  }
  if (need) {
    if (!first) comp_s();
    float tmax = fmaxf(S0[0], S1[0]);
#pragma unroll
    for (int r = 1; r < 16; ++r) tmax = fmaxf(tmax, fmaxf(S0[r], S1[r]));
    tmax = fmaxf(tmax, __shfl_xor(tmax, 32));
    const float d = first ? tmax : fmaxf(tmax, 0.f);
    const float alpha = __builtin_amdgcn_exp2f(-d);
#pragma unroll
    for (int dd = 0; dd < 4; ++dd)
#pragma unroll
      for (int r = 0; r < 16; ++r) O[dd][r] *= alpha;
    lsum *= alpha;
    mrun += d;
#pragma unroll
    for (int r = 0; r < 16; ++r) I[r] = cfar - mrun;
    ps = 0.f;
#pragma unroll
    for (int r = 0; r < 16; ++r) {
      S0[r] = __builtin_amdgcn_exp2f(S0[r] - d); S1[r] = __builtin_amdgcn_exp2f(S1[r] - d);
      ps += S0[r];
      ps += S1[r];
    }
  }
  lsum += ps;
  u32x4 u;
  u[0] = pk2(S0[0], S0[1]); u[1] = pk2(S0[2], S0[3]); u[2] = pk2(S0[4], S0[5]); u[3] = pk2(S0[6], S0[7]);
  const bf16x8 p00 = __builtin_bit_cast(bf16x8, u);
  u[0] = pk2(S0[8], S0[9]); u[1] = pk2(S0[10], S0[11]); u[2] = pk2(S0[12], S0[13]); u[3] = pk2(S0[14], S0[15]);
  const bf16x8 p01 = __builtin_bit_cast(bf16x8, u);
  u[0] = pk2(S1[0], S1[1]); u[1] = pk2(S1[2], S1[3]); u[2] = pk2(S1[4], S1[5]); u[3] = pk2(S1[6], S1[7]);
  const bf16x8 p10 = __builtin_bit_cast(bf16x8, u);
  u[0] = pk2(S1[8], S1[9]); u[1] = pk2(S1[10], S1[11]); u[2] = pk2(S1[12], S1[13]); u[3] = pk2(S1[14], S1[15]);
  const bf16x8 p11 = __builtin_bit_cast(bf16x8, u);
#pragma unroll
  for (int d = 0; d < 4; ++d) {
    const int x0 = vA0 ^ (d << 6), x1 = vA1 ^ (d << 6);
    const bf16x8 f0 = v_frag(vb + x0, vb + x1);
    const bf16x8 f1 = v_frag(vb + x0 + 16 * 256, vb + x1 + 16 * 256);
    const bf16x8 f2 = v_frag(vb + x0 + 32 * 256, vb + x1 + 32 * 256);
    const bf16x8 f3 = v_frag(vb + x0 + 48 * 256, vb + x1 + 48 * 256);
    __builtin_amdgcn_sched_barrier(0);
    O[d] = mfma32(f0, p00, O[d]);
    O[d] = mfma32(f1, p01, O[d]);
    O[d] = mfma32(f2, p10, O[d]);
    O[d] = mfma32(f3, p11, O[d]);
  }
}

DI void attn_item(const Params& p, const char* wsb, int l, int item, char* lds) {
  int tid_ = threadIdx.x; asm volatile("" : "+v"(tid_));
  const int tid = tid_, lane = tid & 63, w = tid >> 6, l31 = lane & 31, h = lane >> 5;
  const int rg = w & 3, mp = w >> 2;
  const int b = item >> 8, hd = item & 7, pi = (item >> 3) & 31;
  const __amdgpu_buffer_rsrc_t rsrc = __builtin_amdgcn_make_buffer_rsrc((void*)wsb, (short)0, 0x7fffffff, 0x00020000);
  float* btab = (float*)(lds + BT_OFF);
  const float lam = p.lam[l];
  const float lam_init = 0.8f - 0.6f * __expf(-0.3f * (float)l);
  __syncthreads();
  for (int i = tid; i < 320; i += NTHR) {
    const int rel = i - 255;
    const int n = rel < 0 ? -rel : rel;
    int bk = n < 8 ? n : (n < 12 ? 8 : (n < 16 ? 9 : (n < 23 ? 10 : (n < 32 ? 11 : (n < 46 ? 12 : (n < 64 ? 13 : (n < 91 ? 14 : 15)))))));
    if (rel > 0) bk += 16;
    btab[i] = (p.rel_bias[bk * 8 + hd] - p.rel_bias[15 * 8 + hd]) * LOG2E;
  }
  const float cfar = p.rel_bias[15 * 8 + hd] * LOG2E;
  const size_t rowbase = (size_t)b * SEQ;
  const int swk = ((l31 & 3) << 2) | ((l31 >> 2) & 3);
  const int ko0 = l31 * 256 + 16 * ((mp * 8 + 0 + h) ^ swk), ko1 = l31 * 256 + 16 * ((mp * 8 + 2 + h) ^ swk);
  const int ko2 = l31 * 256 + 16 * ((mp * 8 + 4 + h) ^ swk), ko3 = l31 * 256 + 16 * ((mp * 8 + 6 + h) ^ swk);
  const int q4 = (lane & 15) >> 2, pp = lane & 3, blk = (lane >> 4) & 1;
  const int vA0 = (4 * h + q4) * 256 + 8 * (pp & 1) + 16 * ((blk * 2 + (pp >> 1)) ^ h) + (q4 << 6);
  const int vA1 = (4 * h + 8 + q4) * 256 + 8 * (pp & 1) + 16 * ((blk * 2 + (pp >> 1)) ^ (h + 2)) + (q4 << 6);
  const int srow = 8 * w + (lane >> 4);
  const int lch = lane & 15;

#pragma unroll 1
  for (int half = 0; half < 2; ++half) {
    const int qb = (pi >= 16) ? (half ? 2 * (pi - 16) : 62 - 2 * (pi - 16)) : (half ? 2 * pi + 1 : 63 - 2 * pi);
    const int q0 = qb * 128, nkt = 2 * qb + 2;
    const int qrow = q0 + 32 * rg + l31;
    const bf16_t* qptr = p.proj + (rowbase + qrow) * DIN + hd * 128 + mp * 64 + h * 8;
    bf16x8 q[4];
#pragma unroll
    for (int s = 0; s < 4; ++s) q[s] = *(const bf16x8*)(qptr + s * 16);
    f32x16 O[4];
#pragma unroll
    for (int d = 0; d < 4; ++d)
#pragma unroll
      for (int r = 0; r < 16; ++r) O[d][r] = 0.f;
    float mrun = 0.f, lsum = 0.f;
    f32x16 I;
#pragma unroll
    for (int r = 0; r < 16; ++r) I[r] = cfar;
    const unsigned kbase = (unsigned)((const char*)(p.proj + rowbase * DIN + 1024 + hd * 128) - wsb);
    auto stage = [&](int kt, int st) {
      char* base = lds + st * ATT_STAGE + w * 2048;
      const unsigned soff = kbase + (unsigned)kt * (64 * DIN * 2);
#pragma unroll
      for (int i = 0; i < 2; ++i) {
        const int row = srow + 4 * i;
        const int c = lch ^ ((((lane >> 4) & 3) << 2) | ((2 * w + i) & 3));
        const unsigned off = (unsigned)((row * DIN + c * 8) * 2);
        __builtin_amdgcn_raw_ptr_buffer_load_lds(rsrc, (lds_void*)(base + i * 1024), 16, off, soff, 0, 0);
        __builtin_amdgcn_raw_ptr_buffer_load_lds(rsrc, (lds_void*)(base + ATT_VOFF + i * 1024), 16, off, soff + 2048u, 0, 0);
      }
    };
    asm volatile("s_waitcnt vmcnt(0)" ::: "memory");
    __syncthreads();
    stage(0, 0);
    asm volatile("s_waitcnt vmcnt(0)" ::: "memory");
    __syncthreads();
    auto step = [&](int kt, auto nearc) {
      constexpr bool NEAR = decltype(nearc)::value;
      if (kt + 1 < nkt) stage(kt + 1, (kt + 1) & 1);
      const char* kb = lds + (kt & 1) * ATT_STAGE;
      const int relb = kt * 64 - qrow + 255 + 4 * h;
      if (kt + 1 < nkt || rg >= 2)
        attn_tile<NEAR>(kb, q, O, mrun, lsum, btab, relb, cfar, ko0, ko1, ko2, ko3, vA0, vA1, kt == 0, I);
      asm volatile("s_waitcnt vmcnt(0)" ::: "memory");
      __syncthreads();
    };
    const int nfar = nkt - 4;
    int kt = 0;
#pragma unroll 1
    for (; kt < nfar; ++kt) step(kt, std::false_type{});
#pragma unroll 1
    for (; kt < nkt; ++kt) step(kt, std::true_type{});
    const float lt = lsum + __shfl_xor(lsum, 32);
    int lane2 = lane; asm volatile("" : "+v"(lane2));
    const int h2 = lane2 >> 5;
    float* xch = (float*)lds + (rg * 64) * 64 + lane2;
    if (mp == 1) {
      const float sc = lam / lt;
#pragma unroll
      for (int d = 0; d < 4; ++d)
#pragma unroll
        for (int r = 0; r < 16; ++r) xch[(d * 16 + r) * 64] = O[d][r] * sc;
    }
    __syncthreads();
    if (mp == 0) {
      const float i0 = 1.f / lt;
      float ssq = 0.f;
#pragma unroll
      for (int d = 0; d < 4; ++d)
#pragma unroll
        for (int r = 0; r < 16; ++r) { const float o = O[d][r] * i0 - xch[(d * 16 + r) * 64]; O[d][r] = o; ssq += o * o; }
      ssq += __shfl_xor(ssq, 32);
      const float rn = rsqrtf(ssq * (1.f / 128.f) + 1e-6f) * (1.f - lam_init);
      const size_t trow = rowbase + q0 + 32 * rg + (lane2 & 31);
      const float* gsp = p.subln_g + l * 128 + 4 * h2;
      const bf16_t* zp = p.proj + trow * DIN + 3072 + hd * 128 + 4 * h2;
      bf16_t* op = p.mixin + trow * DM + hd * 128 + 4 * h2;
#pragma unroll
      for (int d = 0; d < 4; ++d)
#pragma unroll
        for (int g4 = 0; g4 < 4; ++g4) {
          const int dv0 = d * 32 + 8 * g4;
          const f32x4 gs = *(const f32x4*)(gsp + dv0);
          const uint2 z = *(const uint2*)(zp + dv0);
          const float o0 = O[d][4 * g4 + 0] * rn * gs[0] * __uint_as_float(z.x << 16);
          const float o1 = O[d][4 * g4 + 1] * rn * gs[1] * __uint_as_float(z.x & 0xffff0000u);
          const float o2 = O[d][4 * g4 + 2] * rn * gs[2] * __uint_as_float(z.y << 16);
          const float o3 = O[d][4 * g4 + 3] * rn * gs[3] * __uint_as_float(z.y & 0xffff0000u);
          uint2 o; o.x = pk2(o0, o1); o.y = pk2(o2, o3);
          *(uint2*)(op + dv0) = o;
        }
    }
  }
}

DI void resid_row(const Params& p, int l, int row) {
  const int lane = ltid() & 63;
  const bf16_t* mix = p.mix + (size_t)row * DM;
  const float* gp = p.post_g + l * DM;
  float mv[4][8];
  float xv[4][8];
  float ss = 0.f;
#pragma unroll
  for (int i = 0; i < 4; ++i) {
    const int c = lane * 8 + 512 * i;
    const uint4 u = *(const uint4*)(mix + c);
    mv[i][0] = __uint_as_float(u.x << 16); mv[i][1] = __uint_as_float(u.x & 0xffff0000u);
    mv[i][2] = __uint_as_float(u.y << 16); mv[i][3] = __uint_as_float(u.y & 0xffff0000u);
    mv[i][4] = __uint_as_float(u.z << 16); mv[i][5] = __uint_as_float(u.z & 0xffff0000u);
    mv[i][6] = __uint_as_float(u.w << 16); mv[i][7] = __uint_as_float(u.w & 0xffff0000u);
    if (l == 0) {
      const f32x4 xa = *(const f32x4*)(p.x + (size_t)row * DM + c), xc = *(const f32x4*)(p.x + (size_t)row * DM + c + 4);
#pragma unroll
      for (int j = 0; j < 4; ++j) { xv[i][j] = xa[j]; xv[i][4 + j] = xc[j]; }
    } else {
      const uint4 hi = *(const uint4*)(p.xb + (size_t)row * DM + c);
      xv[i][0] = __uint_as_float(hi.x << 16); xv[i][1] = __uint_as_float(hi.x & 0xffff0000u);
      xv[i][2] = __uint_as_float(hi.y << 16); xv[i][3] = __uint_as_float(hi.y & 0xffff0000u);
      xv[i][4] = __uint_as_float(hi.z << 16); xv[i][5] = __uint_as_float(hi.z & 0xffff0000u);
      xv[i][6] = __uint_as_float(hi.w << 16); xv[i][7] = __uint_as_float(hi.w & 0xffff0000u);
    }
#pragma unroll
    for (int j = 0; j < 8; ++j) ss += mv[i][j] * mv[i][j];
  }
  ss = wave_sum(ss);
  const float rs = rsqrtf(ss * (1.f / DM) + 1e-6f);
  float s2 = 0.f;
#pragma unroll
  for (int i = 0; i < 4; ++i) {
    const int c = lane * 8 + 512 * i;
    const f32x4 ga = *(const f32x4*)(gp + c), gb = *(const f32x4*)(gp + c + 4);
    float y[8];
#pragma unroll
    for (int j = 0; j < 4; ++j) { y[j] = xv[i][j] + mv[i][j] * rs * ga[j]; y[4 + j] = xv[i][4 + j] + mv[i][4 + j] * rs * gb[j]; }
    if (l == 3) {
      f32x4 ya = {y[0], y[1], y[2], y[3]}, yb = {y[4], y[5], y[6], y[7]};
      *(f32x4*)(p.out + (size_t)row * DM + c) = ya; *(f32x4*)(p.out + (size_t)row * DM + c + 4) = yb;
    } else {
#pragma unroll
      for (int j = 0; j < 8; ++j) s2 += y[j] * y[j];
      uint4 w; w.x = pk2(y[0], y[1]); w.y = pk2(y[2], y[3]); w.z = pk2(y[4], y[5]); w.w = pk2(y[6], y[7]);
      *(uint4*)(p.xb + (size_t)row * DM + c) = w;
    }
  }
  if (l != 3) {
    s2 = wave_sum(s2);
    if (lane == 0) p.rstd[row] = rsqrtf(s2 * (1.f / DM) + 1e-6f);
  }
}

__global__ void __launch_bounds__(NTHR, 2) mega(Params p) {
  cg::grid_group grid = cg::this_grid();
  __shared__ __attribute__((aligned(16))) char lds[LDS_BYTES];
  const int G = gridDim.x, bid = blockIdx.x, tid = threadIdx.x;
  const char* wsb = (const char*)p.wb_in;
  if (tid == 0) *(uint4*)(lds + XBW_OFF) = make_uint4(0u, 0u, 0u, 0u);
  __syncthreads();
  const XcdBarrier xb = xcd_barrier_post(p.bar, (volatile LAS unsigned*)(lds + XBW_OFF));
  if (p.use_cg) grid.sync();

  for (int it = bid; it < 256 + 4608 + 2048; it += G) {
    if (it < 256) {
      ssm_prep_item(p, it >> 6, it & 63, lds);
    } else if (it < 256 + 4608) {
      const int j = it - 256, l = j / 1152, r = j % 1152;
      if (r < 768) wconv_item(p.w_in + (size_t)l * DM * DIN, DM, DIN, p.wb_in + (size_t)l * DIN * DM, p.pre_g + l * DM, 0, r / 24, r % 24, lds);
      else if (r < 896) { const int r2 = r - 768; wconv_item(p.w_glu + (size_t)l * 1024 * 2048, 1024, 2048, p.wb_glu + (size_t)l * 2048 * 1024, nullptr, 1, r2 / 8, r2 % 8, lds); }
      else { const int r3 = r - 896; wconv_item(p.w_out + (size_t)l * DM * DM, DM, DM, p.wb_out + (size_t)l * DM * DM, nullptr, 0, r3 / 8, r3 % 8, lds); }
    } else {
      const int row = (it - 256 - 4608) * 8 + (ltid() >> 6);
      xprep_row(p.x, row, p.xb, p.rstd);
    }
  }
  xcd_barrier(xb);

#pragma unroll 1
  for (int l = 0; l < 4; ++l) {
    {
      const bf16_t* A = p.xb;
      const bf16_t* Bt = p.wb_in + (size_t)l * DIN * DM;
      for (int rep = 0; rep < REP_P1; ++rep)
      for (int it = bid; it < 64 * 24; it += G) {
        const int mt = it / 24, nt = it % 24;
        const unsigned a0 = (unsigned)((const char*)(A + (size_t)mt * 256 * DM) - wsb);
        const unsigned b0 = (unsigned)((const char*)(Bt + (size_t)nt * 256 * DM) - wsb);
        auto la = [&](int row, int kc, int kt) { return a0 + (unsigned)((row * DM + kt * 64 + kc * 8) * 2); };
        auto lb = [&](int row, int kc, int kt) { return b0 + (unsigned)((row * DM + kt * 64 + kc * 8) * 2); };
        auto epi = [&](f32x4v (&acc)[8][4], int wm, int wn, int l15, int q4) {
          const int seg = nt >> 2;
          const float qs = (seg == 0) ? QSCALE : 1.f;
          const bool act = (seg == 3 || seg == 5);
#pragma unroll
          for (int i = 0; i < 8; ++i) {
            const int m = mt * 256 + wm * 128 + i * 16 + l15;
            const float rs = p.rstd[m] * qs;
            bf16_t* orow = p.proj + (size_t)m * DIN + nt * 256 + wn * 64 + 4 * q4;
            bf16_t* urow = p.mix + ((size_t)((m >> 13) * 64 + (nt - 16) * 16 + wn * 4) * SEQ + (m & (SEQ - 1))) * 16 + 4 * q4;
#pragma unroll
            for (int j = 0; j < 4; ++j) {
              float v0 = acc[i][j][0] * rs, v1 = acc[i][j][1] * rs, v2 = acc[i][j][2] * rs, v3 = acc[i][j][3] * rs;
              if (act) { v0 = silu_f(v0); v1 = silu_f(v1); v2 = silu_f(v2); v3 = silu_f(v3); }
              uint2 o; o.x = pk2(v0, v1); o.y = pk2(v2, v3);
              if (seg == 4) *(uint2*)(urow + (size_t)j * SEQ * 16) = o;
              else *(uint2*)(orow + j * 16) = o;
            }
          }
        };
        gemm_tile16(lds, wsb, DM / 64, la, lb, epi);
      }
    }
    xcd_barrier(xb);
    for (int rep = 0; rep < REP_P3; ++rep)
    for (int it = bid; it < 128 + 512; it += G) {
      if (it < 128) {
        const int g = 8 * (it & 7) + ((it >> 3) & 7), b = it >> 6, bg = b * 64 + g;
        const unsigned a0 = (unsigned)((const char*)(p.Wst + (size_t)(l * 64 + g) * 128 * 1024) - wsb);
        const unsigned u0 = (unsigned)((const char*)(p.mix + (size_t)bg * SEQ * 16) - wsb);
        auto la = [&](int row, int kc, int kt) { return a0 + (unsigned)((row * 1024 + kt * 64 + kc * 8) * 2); };
        auto lb = [&](int row, int kc, int kt) { return u0 + (unsigned)((row * 1024 + kt * 64 + kc * 8) * 2); };
        float* El = (float*)lds;
        auto epi = [&](f32x16 (&acc)[1][2], int wm, int wn, int l31, int h) {
          __syncthreads();
#pragma unroll
          for (int j = 0; j < 2; ++j)
#pragma unroll
              for (int r = 0; r < 16; ++r) {
                const int m = wm * 32 + crow(r, h), n = wn * 64 + j * 32 + l31;
                El[m * 129 + n] = acc[0][j][r];
              }
        };
        gemm_tile<4, 2, 1, false, 4>(lds, wsb, 16, la, lb, epi);
        __syncthreads();
        const int t2 = ltid();
        if (t2 < 64) {
          const int pp = t2;
          const float lr = p.lamL[((l * 64 + g) * 64 + pp) * 2], li = p.lamL[((l * 64 + g) * 64 + pp) * 2 + 1];
          bf16_t* Hb = p.Hb + (size_t)bg * 128 * 128;
          float hr = 0.f, hi = 0.f;
#pragma unroll 4
          for (int c = 0; c < 128; ++c) {
            Hb[c * 128 + pp] = f2bf(hr);
            Hb[c * 128 + 64 + pp] = f2bf(hi);
            const float er = El[pp * 129 + c], ei = El[(pp + 64) * 129 + c];
            const float n2 = lr * hr - li * hi + er;
            hi = lr * hi + li * hr + ei;
            hr = n2;
          }
        }
        __syncthreads();
      } else {
        attn_item(p, wsb, l, it - 128, lds);
      }
    }
    xcd_barrier(xb);
    for (int rep = 0; rep < REP_SSM; ++rep)
    for (int it = bid; it < 512; it += G) {
      const int jj = it & 255, yy = jj >> 3, g = 8 * (jj & 7) + (yy & 7), b = (yy >> 3) & 1, bg = b * 64 + g;
      const int k4 = ((yy >> 4) & 1) + 2 * (it >> 8), mt = (k4 < 2) ? k4 : 5 - k4;
      const int nkT = 4 * (mt + 1);
      const unsigned kc0 = (unsigned)((const char*)(p.Kc + (size_t)(l * 64 + g) * 16 * 64 * 16) - wsb);
      const unsigned wo0 = (unsigned)((const char*)(p.Wo + (size_t)(l * 64 + g) * 1024 * 128) - wsb);
      const unsigned u0 = (unsigned)((const char*)(p.mix + (size_t)bg * SEQ * 16) - wsb);
      const unsigned hb0 = (unsigned)((const char*)(p.Hb + (size_t)bg * 128 * 128) - wsb);
      const unsigned zero = (unsigned)((const char*)p.zero - wsb);
      auto la = [&](int row, int kc, int kt) -> unsigned {
        const int m = mt * 256 + row, t = m >> 4, co = m & 15;
        if (kt < nkT) {
          const int s = kt * 4 + (kc >> 1);
          return (s <= t) ? kc0 + (unsigned)(((co * 64 + (t - s)) * 16 + (kc & 1) * 8) * 2) : zero;
        }
        return wo0 + (unsigned)((m * 128 + (kt - nkT) * 64 + kc * 8) * 2);
      };
      auto lb = [&](int row, int kc, int kt) -> unsigned {
        if (kt < nkT) return u0 + (unsigned)((row * 1024 + kt * 64 + kc * 8) * 2);
        return hb0 + (unsigned)((row * 128 + (kt - nkT) * 64 + kc * 8) * 2);
      };
      auto epi = [&](f32x16 (&acc)[2][2], int wm, int wn, int l31, int h) {
#pragma unroll
        for (int i = 0; i < 2; ++i)
#pragma unroll
          for (int j = 0; j < 2; ++j) {
            const int c = wn * 64 + j * 32 + l31;
#pragma unroll
            for (int g4 = 0; g4 < 4; ++g4) {
              const int m = mt * 256 + wm * 64 + i * 32 + 8 * g4 + 4 * h;
              const int t = m >> 4, co = m & 15;
              const size_t tok = (size_t)b * SEQ + c * 64 + t;
              const int ch = g * 16 + co;
              const uint2 uu = *(const uint2*)(p.mix + ((size_t)bg * SEQ + c * 64 + t) * 16 + co);
              const f32x4 dd = *(const f32x4*)(p.ssm_d + l * 1024 + ch);
              const float y0 = acc[i][j][4 * g4 + 0] + dd[0] * __uint_as_float(uu.x << 16);
              const float y1 = acc[i][j][4 * g4 + 1] + dd[1] * __uint_as_float(uu.x & 0xffff0000u);
              const float y2 = acc[i][j][4 * g4 + 2] + dd[2] * __uint_as_float(uu.y << 16);
              const float y3 = acc[i][j][4 * g4 + 3] + dd[3] * __uint_as_float(uu.y & 0xffff0000u);
              uint2 o; o.x = pk2(gelu_tanh_f(y0), gelu_tanh_f(y1)); o.y = pk2(gelu_tanh_f(y2), gelu_tanh_f(y3));
              *(uint2*)(p.ybuf + tok * 1024 + ch) = o;
            }
          }
      };
      gemm_tile<4, 2, 2, false, 3>(lds, wsb, nkT + 2, la, lb, epi);
    }
    xcd_barrier(xb);
    {
      const bf16_t* Bt = p.wb_glu + (size_t)l * 2048 * 1024;
      for (int rep = 0; rep < REP_P56; ++rep)
      for (int it = bid; it < 64 * 8; it += G) {
        const int xx = it & 7, yy = (it >> 3) & 31, mt = 32 * (it >> 8) + 8 * (xx >> 1) + (yy & 7), nt = 4 * (xx & 1) + (yy >> 3);
        const unsigned a0 = (unsigned)((const char*)(p.ybuf + (size_t)mt * 256 * 1024) - wsb);
        const unsigned b0 = (unsigned)((const char*)(Bt + (size_t)nt * 256 * 1024) - wsb);
        auto la = [&](int row, int kc, int kt) { return a0 + (unsigned)((row * 1024 + kt * 64 + kc * 8) * 2); };
        auto lb = [&](int row, int kc, int kt) { return b0 + (unsigned)((row * 1024 + kt * 64 + kc * 8) * 2); };
        auto epi = [&](f32x4v (&acc)[8][4], int wm, int wn, int l15, int q4) {
          const int jj = (nt * 4 + wn) * 32 + 4 * q4;
#pragma unroll
          for (int i = 0; i < 8; ++i) {
            const size_t m = (size_t)mt * 256 + wm * 128 + i * 16 + l15;
            const bf16_t* zrow = p.proj + m * DIN + 5120 + jj;
            bf16_t* orow = p.mixin + m * DM + 1024 + jj;
#pragma unroll
            for (int j = 0; j < 2; ++j) {
              const uint2 z = *(const uint2*)(zrow + 16 * j);
              const float v0 = acc[i][j][0] * sigmoid_f(acc[i][j + 2][0]) * __uint_as_float(z.x << 16);
              const float v1 = acc[i][j][1] * sigmoid_f(acc[i][j + 2][1]) * __uint_as_float(z.x & 0xffff0000u);
              const float v2 = acc[i][j][2] * sigmoid_f(acc[i][j + 2][2]) * __uint_as_float(z.y << 16);
              const float v3 = acc[i][j][3] * sigmoid_f(acc[i][j + 2][3]) * __uint_as_float(z.y & 0xffff0000u);
              uint2 o; o.x = pk2(v0, v1); o.y = pk2(v2, v3);
              *(uint2*)(orow + 16 * j) = o;
            }
          }
        };
        gemm_tile16(lds, wsb, 16, la, lb, epi);
      }
    }
    xcd_barrier(xb);
    {
      const bf16_t* Bt = p.wb_out + (size_t)l * DM * DM;
      for (int rep = 0; rep < REP_P56; ++rep)
      for (int it = bid; it < 64 * 8; it += G) {
        const int xx = it & 7, yy = (it >> 3) & 31, mt = 32 * (it >> 8) + 8 * (xx >> 1) + (yy & 7), nt = 4 * (xx & 1) + (yy >> 3);
        const unsigned a0 = (unsigned)((const char*)(p.mixin + (size_t)mt * 256 * DM) - wsb);
        const unsigned b0 = (unsigned)((const char*)(Bt + (size_t)nt * 256 * DM) - wsb);
        auto la = [&](int row, int kc, int kt) { return a0 + (unsigned)((row * DM + kt * 64 + kc * 8) * 2); };
        auto lb = [&](int row, int kc, int kt) { return b0 + (unsigned)((row * DM + kt * 64 + kc * 8) * 2); };
        auto epi = [&](f32x4v (&acc)[8][4], int wm, int wn, int l15, int q4) {
#pragma unroll
          for (int i = 0; i < 8; ++i) {
            const size_t m = (size_t)mt * 256 + wm * 128 + i * 16 + l15;
            bf16_t* orow = p.mix + m * DM + nt * 256 + wn * 64 + 4 * q4;
#pragma unroll
            for (int j = 0; j < 4; ++j) {
              uint2 o; o.x = pk2(acc[i][j][0], acc[i][j][1]); o.y = pk2(acc[i][j][2], acc[i][j][3]);
              *(uint2*)(orow + j * 16) = o;
            }
          }
        };
        gemm_tile16(lds, wsb, DM / 64, la, lb, epi);
      }
    }
    xcd_barrier(xb);
    for (int it = bid; it < NTOK / 8; it += G) resid_row(p, l, it * 8 + (ltid() >> 6));
    xcd_barrier(xb);
  }
}

extern "C" void kernel_launch(void* const* d_in, const int* in_sizes, int n_in, void* d_out, int out_size, void* d_ws,
                              size_t ws_size, hipStream_t stream) {
  static int grid_blocks = 0;
  if (!grid_blocks) {
    int dev = 0, cus = 0, per_cu = 0;
    hipGetDevice(&dev);
    hipDeviceGetAttribute(&cus, hipDeviceAttributeMultiprocessorCount, dev);
    hipOccupancyMaxActiveBlocksPerMultiprocessor(&per_cu, mega, NTHR, 0);
    if (per_cu < 1) per_cu = 1;
    if (per_cu > 1) per_cu = 1;
    grid_blocks = cus * per_cu;
  }
  Params p{};
  p.x = (const float*)d_in[0]; p.rel_bias = (const float*)d_in[1]; p.pre_g = (const float*)d_in[2]; p.post_g = (const float*)d_in[3];
  p.w_in = (const float*)d_in[4]; p.lq1 = (const float*)d_in[5]; p.lk1 = (const float*)d_in[6]; p.lq2 = (const float*)d_in[7];
  p.lk2 = (const float*)d_in[8]; p.subln_g = (const float*)d_in[9]; p.a_re = (const float*)d_in[10]; p.a_im = (const float*)d_in[11];
  p.log_dt = (const float*)d_in[12]; p.b_re = (const float*)d_in[13]; p.b_im = (const float*)d_in[14]; p.c_re = (const float*)d_in[15];
  p.c_im = (const float*)d_in[16]; p.ssm_d = (const float*)d_in[17]; p.w_glu = (const float*)d_in[18]; p.w_out = (const float*)d_in[19];
  p.out = (float*)d_out;
  char* ws = (char*)d_ws;
  size_t off = 0;
  auto take = [&](size_t bytes) { char* r = ws + off; off += (bytes + 255) & ~(size_t)255; return r; };
  p.wb_in = (bf16_t*)take((size_t)4 * DIN * DM * 2);
  p.wb_glu = (bf16_t*)take((size_t)4 * 2048 * 1024 * 2);
  p.wb_out = (bf16_t*)take((size_t)4 * DM * DM * 2);
  p.proj = (bf16_t*)take((size_t)NTOK * DIN * 2);
  p.mixin = (bf16_t*)take((size_t)NTOK * DM * 2);
  p.ybuf = (bf16_t*)take((size_t)NTOK * 1024 * 2);
  p.mix = (bf16_t*)take((size_t)NTOK * DM * 2);
  p.xb = (bf16_t*)take((size_t)NTOK * DM * 2);
  p.Kc = (bf16_t*)take((size_t)4 * 64 * 16 * 64 * 16 * 2);
  p.Wst = (bf16_t*)take((size_t)4 * 64 * 128 * 1024 * 2);
  p.Wo = (bf16_t*)take((size_t)4 * 64 * 1024 * 128 * 2);
  p.Hb = (bf16_t*)take((size_t)128 * 128 * 128 * 2);
  p.rstd = (float*)take((size_t)NTOK * 4);
  p.lam = (float*)take(256);
  p.E = nullptr;
  p.xlo = (bf16_t*)take((size_t)NTOK * DM * 2);
  p.lamL = (float*)take((size_t)4 * 64 * 64 * 2 * 4);
  p.zero = (float*)take(256);
  p.bar = (unsigned*)take(XCD_BAR_WORDS * 4);
  p.use_cg = 0ull;
  if (off > ws_size) { fprintf(stderr, "workspace too small: need %zu have %zu\n", off, ws_size); return; }
  (void)hipMemsetAsync(p.bar, 0, XCD_BAR_WORDS * 4, stream);
  void* args[] = {&p};
  hipError_t e = hipLaunchCooperativeKernel((void*)mega, dim3(grid_blocks), dim3(NTHR), args, 0, stream);
  if (e != hipSuccess) fprintf(stderr, "cooperative launch failed: %s (grid %d)\n", hipGetErrorString(e), grid_blocks);
}
```

```cpp
#include <hip/hip_runtime.h>
#include <hip/hip_cooperative_groups.h>
#include <cstdio>
#include <cstdint>
#include <type_traits>
namespace cg = cooperative_groups;

#define DI __device__ __forceinline__
typedef unsigned short bf16_t;
typedef short bf16x8 __attribute__((ext_vector_type(8)));
typedef short s16x4 __attribute__((ext_vector_type(4)));
typedef float f32x16 __attribute__((ext_vector_type(16)));
typedef float f32x4 __attribute__((ext_vector_type(4)));
typedef float f32x2 __attribute__((ext_vector_type(2)));
typedef __bf16 bf2_t __attribute__((ext_vector_type(2)));
typedef __attribute__((address_space(3))) s16x4 lds_s16x4;
typedef __attribute__((address_space(3))) void lds_void;

constexpr int REP_P1 = 1, REP_P3 = 1, REP_SSM = 1, REP_P56 = 1;
constexpr int SEQ = 8192, NTOK = 16384, DM = 2048, DIN = 6144;
constexpr float LOG2E = 1.4426950408889634f;
constexpr float QSCALE = 0.125f * LOG2E;
constexpr int NTHR = 512;
constexpr int LDS_BYTES = 148752;
constexpr int XBW_OFF = 148736;
constexpr int ATT_STAGE = 32768;
constexpr int ATT_VOFF = 16384;
constexpr int BT_OFF = 147456;

struct Params {
  const float *x, *rel_bias, *pre_g, *post_g, *w_in, *lq1, *lk1, *lq2, *lk2, *subln_g, *a_re, *a_im, *log_dt,
      *b_re, *b_im, *c_re, *c_im, *ssm_d, *w_glu, *w_out;
  float* out;
  bf16_t *wb_in, *wb_glu, *wb_out, *proj, *mixin, *ybuf, *mix, *xb, *xlo, *Kc, *Wst, *Wo, *Hb;
  float *rstd, *lam, *E, *lamL, *zero;
  unsigned* bar;
  unsigned long long use_cg;
};

DI int ltid() { int t = threadIdx.x; asm volatile("" : "+v"(t)); return t; }
DI int crow(int r, int h) { return (r & 3) + 8 * (r >> 2) + 4 * h; }
DI float bf2f(bf16_t u) { return __uint_as_float(((unsigned)u) << 16); }
DI unsigned pk2(float a, float b) { f32x2 v = {a, b}; bf2_t r = __builtin_convertvector(v, bf2_t); return __builtin_bit_cast(unsigned, r); }
DI bf16_t f2bf(float a) { return (bf16_t)(pk2(a, 0.f) & 0xffffu); }
DI float wave_sum(float v) {
#pragma unroll
  for (int o = 32; o >= 1; o >>= 1) v += __shfl_xor(v, o);
  return v;
}
DI float silu_f(float v) { return v * __builtin_amdgcn_rcpf(1.f + __expf(-v)); }
DI float sigmoid_f(float v) { return __builtin_amdgcn_rcpf(1.f + __expf(-v)); }
DI float gelu_tanh_f(float v) { const float u = 1.5957691216057308f * (v + 0.044715f * v * v * v); return v * __builtin_amdgcn_rcpf(1.f + __expf(-u)); }
DI f32x16 mfma32(bf16x8 a, bf16x8 b, f32x16 c) { return __builtin_amdgcn_mfma_f32_32x32x16_bf16(a, b, c, 0, 0, 0); }
DI s16x4 tr_read(const char* p) { return __builtin_amdgcn_ds_read_tr16_b64_v4i16((lds_s16x4*)p); }


#define XB_TMO      128
#define XB_XCNT(j)  (256  + 64 * (j))
#define XB_XSUB(j)  (1280 + 64 * (j))
#define XB_XGEN(j)  (2304 + 64 * (j))
#define XB_TOP      3328
#define XB_TOPGEN   3392
#define XCD_BAR_WORDS 3456
#define XB_SPIN_CAP (1u << 22)
#define LAS __attribute__((address_space(3)))
DI unsigned xb_ld(unsigned* p) { return __hip_atomic_load(p, __ATOMIC_RELAXED, __HIP_MEMORY_SCOPE_AGENT); }
DI unsigned xb_add(unsigned* p, unsigned v) { return __hip_atomic_fetch_add(p, v, __ATOMIC_RELAXED, __HIP_MEMORY_SCOPE_AGENT); }
DI unsigned xb_xcc_id() { return (unsigned)__builtin_amdgcn_s_getreg((3 << 11) | 20) & 0xFu; }
#define XB_SPIN(cond, bar) do { unsigned _sp = 0; while (cond) { __builtin_amdgcn_s_sleep(1); \
    if ((++_sp & 255u) == 0u) { if (xb_ld(&(bar)[XB_TMO])) break; if (_sp > XB_SPIN_CAP) { atomicAdd(&(bar)[XB_TMO], 1u); break; } } } } while (0)
struct XcdBarrier { unsigned* bar; unsigned x; volatile LAS unsigned* st; };
DI XcdBarrier xcd_barrier_post(unsigned* bar, volatile LAS unsigned* st) {
  XcdBarrier b; b.bar = bar; b.x = xb_xcc_id(); b.st = st;
  if (threadIdx.x == 0) (void)xb_add(&bar[XB_XCNT(b.x)], 1u);
  return b;
}
DI void xcd_barrier_complete(unsigned* bar, unsigned x, unsigned& nloc, unsigned& nx) {
  const unsigned G = gridDim.x * gridDim.y * gridDim.z;
  unsigned sum, cnt, mine, sp = 0u;
  for (;;) {
    sum = 0u; cnt = 0u; mine = 0u;
#pragma unroll
    for (unsigned j = 0; j < 16; ++j) { const unsigned c = xb_ld(&bar[XB_XCNT(j)]); sum += c; cnt += (c > 0u) ? 1u : 0u; mine = (j == x) ? c : mine; }
    if (sum == G) break;
    __builtin_amdgcn_s_sleep(1);
    if ((++sp & 255u) == 0u) { if (xb_ld(&bar[XB_TMO])) break; if (sp > XB_SPIN_CAP) { atomicAdd(&bar[XB_TMO], 1u); break; } }
  }
  nloc = mine > 0u ? mine : 1u; nx = cnt > 0u ? cnt : 1u;
}
DI void xcd_barrier(const XcdBarrier& b) {
  asm volatile("s_waitcnt vmcnt(0)" ::: "memory");
  __syncthreads();
  if (threadIdx.x == 0) {
    unsigned* bar = b.bar;
    unsigned bx = b.x; asm volatile("" : "+s"(bx));
    __builtin_amdgcn_s_waitcnt(0);
    unsigned nloc = b.st[0], nx = b.st[1];
    if (nloc == 0u) { xcd_barrier_complete(bar, bx, nloc, nx); b.st[0] = nloc; b.st[1] = nx; }
    const unsigned old = xb_add(&bar[XB_XSUB(bx)], 1u);
    const unsigned gen = old / nloc;
    if (old + 1u == (gen + 1u) * nloc) {
      __builtin_amdgcn_fence(__ATOMIC_RELEASE, "agent");
      asm volatile("s_waitcnt vmcnt(0)" ::: "memory");
      const unsigned og = xb_add(&bar[XB_TOP], 1u);
      const unsigned tg = og / nx;
      if (og + 1u == (tg + 1u) * nx) xb_add(&bar[XB_TOPGEN], 1u);
      else XB_SPIN(xb_ld(&bar[XB_TOPGEN]) == tg, bar);
      __builtin_amdgcn_fence(__ATOMIC_ACQUIRE, "agent");
      xb_add(&bar[XB_XGEN(bx)], 1u);
      asm volatile("s_waitcnt vmcnt(0)" ::: "memory");
    } else {
      XB_SPIN(xb_ld(&bar[XB_XGEN(bx)]) == gen, bar);
      __builtin_amdgcn_fence(__ATOMIC_ACQUIRE, "agent");
      asm volatile("s_waitcnt vmcnt(0)" ::: "memory");
    }
  }
  __syncthreads();
}

template <int WM, int WN, int MT, bool TR, int NSTG, class LA, class LB, class EPI>
DI void gemm_tile(char* lds, const char* gbase, int nk, LA la, LB lb, EPI epi) {
  static_assert(WM * WN == 8, "8 waves");
  static_assert(NSTG == 3 || NSTG == 4, "stages");
  constexpr int BM = WM * 32 * MT, BN = WN * 64, NA = BM / 64, NB = BN / 64, NL = NA + NB, BOFF = BM * 128, STG = BOFF + BN * 128;
  static_assert(NSTG * STG <= 147456, "LDS stage area");
  int tid_ = threadIdx.x; asm volatile("" : "+v"(tid_));
  const int tid = tid_, lane = tid & 63, wave = tid >> 6, wm = wave / WN, wn = wave % WN;
  const int l31 = lane & 31, h = lane >> 5;
  const int lr = lane >> 3, gch = lane & 7;
  f32x16 acc[MT][2];
#pragma unroll
  for (int i = 0; i < MT; ++i)
#pragma unroll
    for (int j = 0; j < 2; ++j)
#pragma unroll
      for (int r = 0; r < 16; ++r) acc[i][j][r] = 0.f;
  const __amdgpu_buffer_rsrc_t rsrc = __builtin_amdgcn_make_buffer_rsrc((void*)gbase, (short)0, 0x7fffffff, 0x00020000);
  auto piece = [&](int kt, int st, int i) {
    char* base = lds + st * STG;
    if (i < NA) {
      const int row = 8 * (wave * NA + i) + lr;
      const int c = gch ^ ((row >> 1) & 7);
      __builtin_amdgcn_raw_ptr_buffer_load_lds(rsrc, (lds_void*)(base + (wave * NA + i) * 1024), 16, la(row, c, kt), 0, 0, 0);
    } else {
      const int i2 = i - NA;
      const int row = 8 * (wave * NB + i2) + lr;
      const int c = gch ^ ((row >> 1) & 7);
      __builtin_amdgcn_raw_ptr_buffer_load_lds(rsrc, (lds_void*)(base + BOFF + (wave * NB + i2) * 1024), 16, lb(row, c, kt), 0, 0, 0);
    }
  };
  const int xs = (l31 >> 1) & 7;
  const int arow = (wm * 32 * MT + l31) * 128, brow = BOFF + (wn * 64 + l31) * 128;
#pragma unroll
  for (int t = 0; t < NSTG - 1; ++t)
    if (t < nk) {
#pragma unroll
      for (int i = 0; i < NL; ++i) piece(t, t, i);
    }
  auto rd = [&](const char* a, int s, bf16x8 (&af)[MT], bf16x8 (&bf)[2]) {
    const int co = 16 * ((2 * s + h) ^ xs);
#pragma unroll
    for (int j = 0; j < 2; ++j) bf[j] = *(const bf16x8*)(a + brow + j * 4096 + co);
#pragma unroll
    for (int i = 0; i < MT; ++i) af[i] = *(const bf16x8*)(a + arow + i * 4096 + co);
  };
  int sc = 0;
#pragma unroll 1
  for (int kt = 0; kt < nk; ++kt) {
    if (NSTG >= 4 && kt + 2 < nk) asm volatile("s_waitcnt vmcnt(%0)" ::"n"(2 * NL) : "memory");
    else if (kt + 1 < nk) asm volatile("s_waitcnt vmcnt(%0)" ::"n"(NL) : "memory");
    else asm volatile("s_waitcnt vmcnt(0)" ::: "memory");
    __builtin_amdgcn_s_barrier();
    asm volatile("" ::: "memory");
    const bool more = (kt + NSTG - 1 < nk);
    const int sf = (sc == 0) ? NSTG - 1 : sc - 1;
    const char* a0 = lds + sc * STG;
    bf16x8 af0[MT], af1[MT], bf0[2], bf1[2];
    rd(a0, 0, af0, bf0);
    rd(a0, 1, af1, bf1);
    __builtin_amdgcn_sched_barrier(0);
#pragma unroll
    for (int s = 0; s < 4; ++s) {
      bf16x8 (&af)[MT] = (s & 1) ? af1 : af0;
      bf16x8 (&bf)[2] = (s & 1) ? bf1 : bf0;
#pragma unroll
      for (int i = 0; i < MT; ++i) {
        acc[i][0] = TR ? mfma32(bf[0], af[i], acc[i][0]) : mfma32(af[i], bf[0], acc[i][0]);
        acc[i][1] = TR ? mfma32(bf[1], af[i], acc[i][1]) : mfma32(af[i], bf[1], acc[i][1]);
        if (s < 2) {
          __builtin_amdgcn_sched_barrier(0);
          const int pi = s * MT + i;
          if (pi < NL) { if (more) piece(kt + NSTG - 1, sf, pi); }
          __builtin_amdgcn_sched_barrier(0);
        }
      }
      if (s == 1) {
#pragma unroll
        for (int pi = 2 * MT; pi < NL; ++pi) { if (more) piece(kt + NSTG - 1, sf, pi); }
      }
      __builtin_amdgcn_sched_barrier(0);
      if (s < 2) { rd(a0, s + 2, af, bf); __builtin_amdgcn_sched_barrier(0); }
    }
    sc = (sc == NSTG - 1) ? 0 : sc + 1;
  }
  epi(acc, wm, wn, l31, h);
  __syncthreads();
}

typedef float f32x4v __attribute__((ext_vector_type(4)));
DI f32x4v mfma16(bf16x8 a, bf16x8 b, f32x4v c) { return __builtin_amdgcn_mfma_f32_16x16x32_bf16(a, b, c, 0, 0, 0); }
template <class LA, class LB, class EPI>
DI void gemm_tile16(char* lds, const char* gbase, int nk, LA la, LB lb, EPI epi) {
  constexpr int STG = 65536, BOFF = 32768, NL = 8;
  int tid_ = threadIdx.x; asm volatile("" : "+v"(tid_));
  const int tid = tid_, lane = tid & 63, wave = tid >> 6, wm = wave >> 2, wn = wave & 3;
  const int l15 = lane & 15, q4 = lane >> 4;
  const int lr = lane >> 3, gch = lane & 7;
  f32x4v acc[8][4];
#pragma unroll
  for (int i = 0; i < 8; ++i)
#pragma unroll
    for (int j = 0; j < 4; ++j)
#pragma unroll
      for (int e = 0; e < 4; ++e) acc[i][j][e] = 0.f;
  const __amdgpu_buffer_rsrc_t rsrc = __builtin_amdgcn_make_buffer_rsrc((void*)gbase, (short)0, 0x7fffffff, 0x00020000);
  auto piece = [&](int kt, int i) {
    char* base = lds + (kt & 1) * STG;
    if (i < 4) {
      const int row = 8 * (wave * 4 + i) + lr;
      const int c = gch ^ ((row >> 1) & 7);
      __builtin_amdgcn_raw_ptr_buffer_load_lds(rsrc, (lds_void*)(base + (wave * 4 + i) * 1024), 16, la(row, c, kt), 0, 0, 0);
    } else {
      const int i2 = i - 4;
      const int row = 8 * (wave * 4 + i2) + lr;
      const int c = gch ^ ((row >> 1) & 7);
      __builtin_amdgcn_raw_ptr_buffer_load_lds(rsrc, (lds_void*)(base + BOFF + (wave * 4 + i2) * 1024), 16, lb(row, c, kt), 0, 0, 0);
    }
  };
  const int xs = (l15 >> 1) & 7;
  const int arow = (wm * 128 + l15) * 128, brow = BOFF + (wn * 64 + l15) * 128;
  const int co0 = 16 * (q4 ^ xs), co1 = 16 * ((4 + q4) ^ xs);
#pragma unroll
  for (int i = 0; i < NL; ++i) piece(0, i);
  auto rdB = [&](const char* a, int co, bf16x8 (&bf)[4]) {
#pragma unroll
    for (int j = 0; j < 4; ++j) bf[j] = *(const bf16x8*)(a + brow + j * 2048 + co);
  };
  auto rdA = [&](const char* a, int co, int half, bf16x8 (&af)[4]) {
#pragma unroll
    for (int i = 0; i < 4; ++i) af[i] = *(const bf16x8*)(a + arow + (half * 4 + i) * 2048 + co);
  };
#pragma unroll 1
  for (int kt = 0; kt < nk; ++kt) {
    asm volatile("s_waitcnt vmcnt(0)" ::: "memory");
    __builtin_amdgcn_s_barrier();
    asm volatile("" ::: "memory");
    const bool more = (kt + 1 < nk);
    const char* a0 = lds + (kt & 1) * STG;
    bf16x8 B0[4], B1[4], Alo[4], Ahi[4];
    Alo[0] = *(const bf16x8*)(a0 + arow + co0);
    rdB(a0, co0, B0);
#pragma unroll
    for (int i = 1; i < 4; ++i) Alo[i] = *(const bf16x8*)(a0 + arow + i * 2048 + co0);
    rdA(a0, co0, 1, Ahi);
    __builtin_amdgcn_sched_barrier(0);
#pragma unroll
    for (int i = 0; i < 4; ++i) {
#pragma unroll
      for (int j = 0; j < 4; ++j) acc[i][j] = mfma16(B0[j], Alo[i], acc[i][j]);
      __builtin_amdgcn_sched_barrier(0);
      if (more) piece(kt + 1, i);
      __builtin_amdgcn_sched_barrier(0);
    }
    rdB(a0, co1, B1);
    rdA(a0, co1, 0, Alo);
    __builtin_amdgcn_sched_barrier(0);
#pragma unroll
    for (int i = 0; i < 4; ++i) {
#pragma unroll
      for (int j = 0; j < 4; ++j) acc[4 + i][j] = mfma16(B0[j], Ahi[i], acc[4 + i][j]);
      __builtin_amdgcn_sched_barrier(0);
      if (more) piece(kt + 1, 4 + i);
      __builtin_amdgcn_sched_barrier(0);
    }
    rdA(a0, co1, 1, Ahi);
    __builtin_amdgcn_sched_barrier(0);
#pragma unroll
    for (int i = 0; i < 4; ++i)
#pragma unroll
      for (int j = 0; j < 4; ++j) acc[i][j] = mfma16(B1[j], Alo[i], acc[i][j]);
    __builtin_amdgcn_sched_barrier(0);
#pragma unroll
    for (int i = 0; i < 4; ++i)
#pragma unroll
      for (int j = 0; j < 4; ++j) acc[4 + i][j] = mfma16(B1[j], Ahi[i], acc[4 + i][j]);
  }
  epi(acc, wm, wn, l15, q4);
  __syncthreads();
}

DI void wconv_item(const float* __restrict__ src, int K, int N, bf16_t* __restrict__ dst, const float* __restrict__ gain,
                   int glu_perm, int kt, int ng, char* lds) {
  float* tile = (float*)lds;
  int tid_ = threadIdx.x; asm volatile("" : "+v"(tid_));
  const int tid = tid_;
  __syncthreads();
  f32x4 v[8];
#pragma unroll
  for (int i = 0; i < 8; ++i) {
    const int kk = i * 8 + (tid >> 6), n4 = (tid & 63) * 4;
    const int np = ng * 256 + n4;
    int sc = np;
    if (glu_perm) { const int blk = np >> 6, w = np & 63; const int j = blk * 32 + (w & 31); sc = (w < 32) ? j : 1024 + j; }
    v[i] = *(const f32x4*)(src + (size_t)(kt * 64 + kk) * N + sc);
  }
#pragma unroll
  for (int i = 0; i < 8; ++i) {
    const int kk = i * 8 + (tid >> 6), n4 = (tid & 63) * 4;
    if (gain) { const float gg = gain[kt * 64 + kk]; v[i][0] *= gg; v[i][1] *= gg; v[i][2] *= gg; v[i][3] *= gg; }
    *(f32x4*)(tile + kk * 260 + n4) = v[i];
  }
  __syncthreads();
#pragma unroll
  for (int i = 0; i < 4; ++i) {
    const int nn = (tid & 63) + 64 * (i & 3), kc = tid >> 6;
    uint4 w;
    w.x = pk2(tile[(kc * 8 + 0) * 260 + nn], tile[(kc * 8 + 1) * 260 + nn]);
    w.y = pk2(tile[(kc * 8 + 2) * 260 + nn], tile[(kc * 8 + 3) * 260 + nn]);
    w.z = pk2(tile[(kc * 8 + 4) * 260 + nn], tile[(kc * 8 + 5) * 260 + nn]);
    w.w = pk2(tile[(kc * 8 + 6) * 260 + nn], tile[(kc * 8 + 7) * 260 + nn]);
    *(uint4*)(dst + (size_t)(ng * 256 + nn) * K + kt * 64 + kc * 8) = w;
  }
}

DI void xprep_row(const float* __restrict__ x, int row, bf16_t* __restrict__ xb, float* __restrict__ rstd) {
  const int lane = ltid() & 63;
  const float* src = x + (size_t)row * DM;
  float ss = 0.f;
#pragma unroll
  for (int i = 0; i < 4; ++i) {
    const int c = lane * 8 + 512 * i;
    const f32x4 a = *(const f32x4*)(src + c), b = *(const f32x4*)(src + c + 4);
    ss += a[0] * a[0] + a[1] * a[1] + a[2] * a[2] + a[3] * a[3] + b[0] * b[0] + b[1] * b[1] + b[2] * b[2] + b[3] * b[3];
    uint4 w; w.x = pk2(a[0], a[1]); w.y = pk2(a[2], a[3]); w.z = pk2(b[0], b[1]); w.w = pk2(b[2], b[3]);
    *(uint4*)(xb + (size_t)row * DM + c) = w;
  }
  ss = wave_sum(ss);
  if (lane == 0) rstd[row] = rsqrtf(ss * (1.f / DM) + 1e-6f);
}

DI void ssm_prep_item(const Params& p, int l, int g, char* lds) {
  float* pwre = (float*)lds;
  float* pwim = pwre + 65 * 65;
  float* Bre = pwim + 65 * 65;
  float* Bim = Bre + 1024;
  float* Cre = Bim + 1024;
  float* Cim = Cre + 1040;
  float* cfre = Cim + 1040;
  float* cfim = cfre + 64;
  int tid_ = threadIdx.x; asm volatile("" : "+v"(tid_));
  const int tid = tid_;
  const int lg = l * 64 + g;
  __syncthreads();
  if (tid < 64) {
    const int pp = tid;
    const double dt = exp((double)p.log_dt[lg]);
    const double ar = p.a_re[lg * 64 + pp], ai = p.a_im[lg * 64 + pp];
    const double mag = exp(dt * ar), lr = mag * cos(dt * ai), li = mag * sin(dt * ai);
    const double den = ar * ar + ai * ai, nr = lr - 1.0;
    cfre[pp] = (float)((nr * ar + li * ai) / den);
    cfim[pp] = (float)((li * ar - nr * ai) / den);
    double wr = 1.0, wi = 0.0;
#pragma unroll 1
    for (int t = 0; t <= 64; ++t) {
      pwre[t * 65 + pp] = (float)wr; pwim[t * 65 + pp] = (float)wi;
      const double n2 = wr * lr - wi * li; wi = wr * li + wi * lr; wr = n2;
    }
    p.lamL[(lg * 64 + pp) * 2] = pwre[64 * 65 + pp];
    p.lamL[(lg * 64 + pp) * 2 + 1] = pwim[64 * 65 + pp];
  }
  for (int e = tid; e < 1024; e += NTHR) { Cre[(e >> 6) * 65 + (e & 63)] = p.c_re[lg * 1024 + e]; Cim[(e >> 6) * 65 + (e & 63)] = p.c_im[lg * 1024 + e]; }
  if (l == 0 && g == 0 && tid < 64) p.zero[tid] = 0.f;
  if (g == 0 && tid == 0) {
    float s1 = 0.f, s2 = 0.f;
    for (int i = 0; i < 64; ++i) { s1 += p.lq1[l * 64 + i] * p.lk1[l * 64 + i]; s2 += p.lq2[l * 64 + i] * p.lk2[l * 64 + i]; }
    const float lam_init = 0.8f - 0.6f * expf(-0.3f * (float)l);
    p.lam[l] = expf(s1) - expf(s2) + lam_init;
  }
  __syncthreads();
  for (int e = tid; e < 1024; e += NTHR) {
    const int pp = e >> 4;
    const float br = p.b_re[lg * 1024 + e], bi = p.b_im[lg * 1024 + e];
    Bre[e] = cfre[pp] * br - cfim[pp] * bi;
    Bim[e] = cfre[pp] * bi + cfim[pp] * br;
  }
  __syncthreads();
#pragma unroll 1
  for (int q = 0; q < 2; ++q) {
    const int idx = tid + NTHR * q, co = idx >> 6, tau = idx & 63;
    float acc[16];
#pragma unroll
    for (int c = 0; c < 16; ++c) acc[c] = 0.f;
#pragma unroll 2
    for (int pp = 0; pp < 64; ++pp) {
      const float cr = Cre[co * 65 + pp], ci = Cim[co * 65 + pp], wr = pwre[tau * 65 + pp], wi = pwim[tau * 65 + pp];
      const float xr = cr * wr - ci * wi, xi = cr * wi + ci * wr;
#pragma unroll
      for (int c = 0; c < 16; ++c) acc[c] += xr * Bre[pp * 16 + c] - xi * Bim[pp * 16 + c];
    }
    uint4 w0, w1;
    w0.x = pk2(acc[0], acc[1]); w0.y = pk2(acc[2], acc[3]); w0.z = pk2(acc[4], acc[5]); w0.w = pk2(acc[6], acc[7]);
    w1.x = pk2(acc[8], acc[9]); w1.y = pk2(acc[10], acc[11]); w1.z = pk2(acc[12], acc[13]); w1.w = pk2(acc[14], acc[15]);
    bf16_t* d = p.Kc + ((size_t)(lg * 16 + co) * 64 + tau) * 16;
    *(uint4*)d = w0; *(uint4*)(d + 8) = w1;
  }
#pragma unroll 1
  for (int q = 0; q < 16; ++q) {
    const int idx = tid + NTHR * q, pr = idx >> 6, s = idx & 63, pp = pr & 63;
    const float wr = pwre[(63 - s) * 65 + pp], wi = pwim[(63 - s) * 65 + pp];
    float v[16];
#pragma unroll
    for (int c = 0; c < 16; ++c) {
      const float br = Bre[pp * 16 + c], bi = Bim[pp * 16 + c];
      v[c] = (pr < 64) ? (wr * br - wi * bi) : (wr * bi + wi * br);
    }
    uint4 w0, w1;
    w0.x = pk2(v[0], v[1]); w0.y = pk2(v[2], v[3]); w0.z = pk2(v[4], v[5]); w0.w = pk2(v[6], v[7]);
    w1.x = pk2(v[8], v[9]); w1.y = pk2(v[10], v[11]); w1.z = pk2(v[12], v[13]); w1.w = pk2(v[14], v[15]);
    bf16_t* d = p.Wst + ((size_t)(lg * 128 + pr)) * 1024 + s * 16;
    *(uint4*)d = w0; *(uint4*)(d + 8) = w1;
  }
#pragma unroll 1
  for (int q = 0; q < 32; ++q) {
    const int idx = tid + NTHR * q, m = idx >> 4, ch = idx & 15, t = m >> 4, co = m & 15;
    float v[8];
#pragma unroll
    for (int j = 0; j < 8; ++j) {
      const int pr = ch * 8 + j, pp = pr & 63;
      const float cr = Cre[co * 65 + pp], ci = Cim[co * 65 + pp], wr = pwre[(t + 1) * 65 + pp], wi = pwim[(t + 1) * 65 + pp];
      v[j] = (pr < 64) ? (cr * wr - ci * wi) : -(cr * wi + ci * wr);
    }
    uint4 w0;
    w0.x = pk2(v[0], v[1]); w0.y = pk2(v[2], v[3]); w0.z = pk2(v[4], v[5]); w0.w = pk2(v[6], v[7]);
    *(uint4*)(p.Wo + ((size_t)(lg * 1024 + m)) * 128 + ch * 8) = w0;
  }
}

typedef unsigned u32x4 __attribute__((ext_vector_type(4)));

DI bf16x8 v_frag(const char* a0, const char* a1) {
  const s16x4 lo = tr_read(a0);
  const s16x4 hi = tr_read(a1);
  return __builtin_shufflevector(lo, hi, 0, 1, 2, 3, 4, 5, 6, 7);
}

template <bool NEAR>
DI void attn_tile(const char* kb, const bf16x8 (&q)[4], f32x16 (&O)[4], float& mrun, float& lsum,
                  const float* btab, int relb, float cfar, int ko0, int ko1, int ko2, int ko3, int vA0, int vA1, bool first, f32x16& I) {
  f32x16 S0, S1;
  auto comp_s = [&]() {
    const bf16x8 k00 = *(const bf16x8*)(kb + ko0), k10 = *(const bf16x8*)(kb + ko0 + 8192);
    const bf16x8 k01 = *(const bf16x8*)(kb + ko1), k11 = *(const bf16x8*)(kb + ko1 + 8192);
    const bf16x8 k02 = *(const bf16x8*)(kb + ko2), k12 = *(const bf16x8*)(kb + ko2 + 8192);
    const bf16x8 k03 = *(const bf16x8*)(kb + ko3), k13 = *(const bf16x8*)(kb + ko3 + 8192);
    __builtin_amdgcn_sched_barrier(0);
    S0 = mfma32(k00, q[0], I); S1 = mfma32(k10, q[0], I);
    S0 = mfma32(k01, q[1], S0); S1 = mfma32(k11, q[1], S1);
    S0 = mfma32(k02, q[2], S0); S1 = mfma32(k12, q[2], S1);
    S0 = mfma32(k03, q[3], S0); S1 = mfma32(k13, q[3], S1);
    if (NEAR) {
#pragma unroll
      for (int r = 0; r < 16; ++r) {
        S0[r] += btab[relb + (r & 3) + 8 * (r >> 2)];
        S1[r] += btab[relb + 32 + (r & 3) + 8 * (r >> 2)];
      }
    }
  };
  comp_s();
  const char* vb = kb + ATT_VOFF;
  bool need = first;
  float ps = 0.f;
  if (!first) {
#pragma unroll
    for (int r = 0; r < 16; ++r) {
      S0[r] = __builtin_amdgcn_exp2f(S0[r]); S1[r] = __builtin_amdgcn_exp2f(S1[r]);
      ps += S0[r];
      ps += S1[r];
    }
    need = __any(!(ps <= 1048576.f));
  }
  if (need) {
    if (!first) comp_s();
    float tmax = fmaxf(S0[0], S1[0]);
#pragma unroll
    for (int r = 1; r < 16; ++r) tmax = fmaxf(tmax, fmaxf(S0[r], S1[r]));
    tmax = fmaxf(tmax, __shfl_xor(tmax, 32));
    const float d = first ? tmax : fmaxf(tmax, 0.f);
    const float alpha = __builtin_amdgcn_exp2f(-d);
#pragma unroll
    for (int dd = 0; dd < 4; ++dd)
#pragma unroll
      for (int r = 0; r < 16; ++r) O[dd][r] *= alpha;
    lsum *= alpha;
    mrun += d;
#pragma unroll
    for (int r = 0; r < 16; ++r) I[r] = cfar - mrun;
    ps = 0.f;
#pragma unroll
    for (int r = 0; r < 16; ++r) {
      S0[r] = __builtin_amdgcn_exp2f(S0[r] - d); S1[r] = __builtin_amdgcn_exp2f(S1[r] - d);
      ps += S0[r];
      ps += S1[r];
    }
  }
  lsum += ps;
  u32x4 u;
  u[0] = pk2(S0[0], S0[1]); u[1] = pk2(S0[2], S0[3]); u[2] = pk2(S0[4], S0[5]); u[3] = pk2(S0[6], S0[7]);
  const bf16x8 p00 = __builtin_bit_cast(bf16x8, u);
  u[0] = pk2(S0[8], S0[9]); u[1] = pk2(S0[10], S0[11]); u[2] = pk2(S0[12], S0[13]); u[3] = pk2(S0[14], S0[15]);
  const bf16x8 p01 = __builtin_bit_cast(bf16x8, u);
  u[0] = pk2(S1[0], S1[1]); u[1] = pk2(S1[2], S1[3]); u[2] = pk2(S1[4], S1[5]); u[3] = pk2(S1[6], S1[7]);
  const bf16x8 p10 = __builtin_bit_cast(bf16x8, u);
  u[0] = pk2(S1[8], S1[9]); u[1] = pk2(S1[10], S1[11]); u[2] = pk2(S1[12], S1[13]); u[3] = pk2(S1[14], S1[15]);
  const bf16x8 p11 = __builtin_bit_cast(bf16x8, u);
#pragma unroll
  for (int d = 0; d < 4; ++d) {
    const int x0 = vA0 ^ (d << 6), x1 = vA1 ^ (d << 6);
    const bf16x8 f0 = v_frag(vb + x0, vb + x1);
    const bf16x8 f1 = v_frag(vb + x0 + 16 * 256, vb + x1 + 16 * 256);
    const bf16x8 f2 = v_frag(vb + x0 + 32 * 256, vb + x1 + 32 * 256);
    const bf16x8 f3 = v_frag(vb + x0 + 48 * 256, vb + x1 + 48 * 256);
    __builtin_amdgcn_sched_barrier(0);
    O[d] = mfma32(f0, p00, O[d]);
    O[d] = mfma32(f1, p01, O[d]);
    O[d] = mfma32(f2, p10, O[d]);
    O[d] = mfma32(f3, p11, O[d]);
  }
}

DI void attn_item(const Params& p, const char* wsb, int l, int item, char* lds) {
  int tid_ = threadIdx.x; asm volatile("" : "+v"(tid_));
  const int tid = tid_, lane = tid & 63, w = tid >> 6, l31 = lane & 31, h = lane >> 5;
  const int rg = w & 3, mp = w >> 2;
  const int b = item >> 8, hd = item & 7, pi = (item >> 3) & 31;
  const __amdgpu_buffer_rsrc_t rsrc = __builtin_amdgcn_make_buffer_rsrc((void*)wsb, (short)0, 0x7fffffff, 0x00020000);
  float* btab = (float*)(lds + BT_OFF);
  const float lam = p.lam[l];
  const float lam_init = 0.8f - 0.6f * __expf(-0.3f * (float)l);
  __syncthreads();
  for (int i = tid; i < 320; i += NTHR) {
    const int rel = i - 255;
    const int n = rel < 0 ? -rel : rel;
    int bk = n < 8 ? n : (n < 12 ? 8 : (n < 16 ? 9 : (n < 23 ? 10 : (n < 32 ? 11 : (n < 46 ? 12 : (n < 64 ? 13 : (n < 91 ? 14 : 15)))))));
    if (rel > 0) bk += 16;
    btab[i] = (p.rel_bias[bk * 8 + hd] - p.rel_bias[15 * 8 + hd]) * LOG2E;
  }
  const float cfar = p.rel_bias[15 * 8 + hd] * LOG2E;
  const size_t rowbase = (size_t)b * SEQ;
  const int swk = ((l31 & 3) << 2) | ((l31 >> 2) & 3);
  const int ko0 = l31 * 256 + 16 * ((mp * 8 + 0 + h) ^ swk), ko1 = l31 * 256 + 16 * ((mp * 8 + 2 + h) ^ swk);
  const int ko2 = l31 * 256 + 16 * ((mp * 8 + 4 + h) ^ swk), ko3 = l31 * 256 + 16 * ((mp * 8 + 6 + h) ^ swk);
  const int q4 = (lane & 15) >> 2, pp = lane & 3, blk = (lane >> 4) & 1;
  const int vA0 = (4 * h + q4) * 256 + 8 * (pp & 1) + 16 * ((blk * 2 + (pp >> 1)) ^ h) + (q4 << 6);
  const int vA1 = (4 * h + 8 + q4) * 256 + 8 * (pp & 1) + 16 * ((blk * 2 + (pp >> 1)) ^ (h + 2)) + (q4 << 6);
  const int srow = 8 * w + (lane >> 4);
  const int lch = lane & 15;

#pragma unroll 1
  for (int half = 0; half < 2; ++half) {
    const int qb = (pi >= 16) ? (half ? 2 * (pi - 16) : 62 - 2 * (pi - 16)) : (half ? 2 * pi + 1 : 63 - 2 * pi);
    const int q0 = qb * 128, nkt = 2 * qb + 2;
    const int qrow = q0 + 32 * rg + l31;
    const bf16_t* qptr = p.proj + (rowbase + qrow) * DIN + hd * 128 + mp * 64 + h * 8;
    bf16x8 q[4];
#pragma unroll
    for (int s = 0; s < 4; ++s) q[s] = *(const bf16x8*)(qptr + s * 16);
    f32x16 O[4];
#pragma unroll
    for (int d = 0; d < 4; ++d)
#pragma unroll
      for (int r = 0; r < 16; ++r) O[d][r] = 0.f;
    float mrun = 0.f, lsum = 0.f;
    f32x16 I;
#pragma unroll
    for (int r = 0; r < 16; ++r) I[r] = cfar;
    const unsigned kbase = (unsigned)((const char*)(p.proj + rowbase * DIN + 1024 + hd * 128) - wsb);
    auto stage = [&](int kt, int st) {
      char* base = lds + st * ATT_STAGE + w * 2048;
      const unsigned soff = kbase + (unsigned)kt * (64 * DIN * 2);
#pragma unroll
      for (int i = 0; i < 2; ++i) {
        const int row = srow + 4 * i;
        const int c = lch ^ ((((lane >> 4) & 3) << 2) | ((2 * w + i) & 3));
        const unsigned off = (unsigned)((row * DIN + c * 8) * 2);
        __builtin_amdgcn_raw_ptr_buffer_load_lds(rsrc, (lds_void*)(base + i * 1024), 16, off, soff, 0, 0);
        __builtin_amdgcn_raw_ptr_buffer_load_lds(rsrc, (lds_void*)(base + ATT_VOFF + i * 1024), 16, off, soff + 2048u, 0, 0);
      }
    };
    asm volatile("s_waitcnt vmcnt(0)" ::: "memory");
    __syncthreads();
    stage(0, 0);
    asm volatile("s_waitcnt vmcnt(0)" ::: "memory");
    __syncthreads();
    auto step = [&](int kt, auto nearc) {
      constexpr bool NEAR = decltype(nearc)::value;
      if (kt + 1 < nkt) stage(kt + 1, (kt + 1) & 1);
      const char* kb = lds + (kt & 1) * ATT_STAGE;
      const int relb = kt * 64 - qrow + 255 + 4 * h;
      if (kt + 1 < nkt || rg >= 2)
        attn_tile<NEAR>(kb, q, O, mrun, lsum, btab, relb, cfar, ko0, ko1, ko2, ko3, vA0, vA1, kt == 0, I);
      asm volatile("s_waitcnt vmcnt(0)" ::: "memory");
      __syncthreads();
    };
    const int nfar = nkt - 4;
    int kt = 0;
#pragma unroll 1
    for (; kt < nfar; ++kt) step(kt, std::false_type{});
#pragma unroll 1
    for (; kt < nkt; ++kt) step(kt, std::true_type{});
    const float lt = lsum + __shfl_xor(lsum, 32);
    int lane2 = lane; asm volatile("" : "+v"(lane2));
    const int h2 = lane2 >> 5;
    float* xch = (float*)lds + (rg * 64) * 64 + lane2;
    if (mp == 1) {
      const float sc = lam / lt;
#pragma unroll
      for (int d = 0; d < 4; ++d)
#pragma unroll
        for (int r = 0; r < 16; ++r) xch[(d * 16 + r) * 64] = O[d][r] * sc;
    }
    __syncthreads();
    if (mp == 0) {
      const float i0 = 1.f / lt;
      float ssq = 0.f;
#pragma unroll
      for (int d = 0; d < 4; ++d)
#pragma unroll
        for (int r = 0; r < 16; ++r) { const float o = O[d][r] * i0 - xch[(d * 16 + r) * 64]; O[d][r] = o; ssq += o * o; }
      ssq += __shfl_xor(ssq, 32);
      const float rn = rsqrtf(ssq * (1.f / 128.f) + 1e-6f) * (1.f - lam_init);
      const size_t trow = rowbase + q0 + 32 * rg + (lane2 & 31);
      const float* gsp = p.subln_g + l * 128 + 4 * h2;
      const bf16_t* zp = p.proj + trow * DIN + 3072 + hd * 128 + 4 * h2;
      bf16_t* op = p.mixin + trow * DM + hd * 128 + 4 * h2;
#pragma unroll
      for (int d = 0; d < 4; ++d)
#pragma unroll
        for (int g4 = 0; g4 < 4; ++g4) {
          const int dv0 = d * 32 + 8 * g4;
          const f32x4 gs = *(const f32x4*)(gsp + dv0);
          const uint2 z = *(const uint2*)(zp + dv0);
          const float o0 = O[d][4 * g4 + 0] * rn * gs[0] * __uint_as_float(z.x << 16);
          const float o1 = O[d][4 * g4 + 1] * rn * gs[1] * __uint_as_float(z.x & 0xffff0000u);
          const float o2 = O[d][4 * g4 + 2] * rn * gs[2] * __uint_as_float(z.y << 16);
          const float o3 = O[d][4 * g4 + 3] * rn * gs[3] * __uint_as_float(z.y & 0xffff0000u);
          uint2 o; o.x = pk2(o0, o1); o.y = pk2(o2, o3);
          *(uint2*)(op + dv0) = o;
        }
    }
  }
}

DI void resid_row(const Params& p, int l, int row) {
  const int lane = ltid() & 63;
  const bf16_t* mix = p.mix + (size_t)row * DM;
  const float* gp = p.post_g + l * DM;
  float mv[4][8];
  float xv[4][8];
  float ss = 0.f;
#pragma unroll
  for (int i = 0; i < 4; ++i) {
    const int c = lane * 8 + 512 * i;
    const uint4 u = *(const uint4*)(mix + c);
    mv[i][0] = __uint_as_float(u.x << 16); mv[i][1] = __uint_as_float(u.x & 0xffff0000u);
    mv[i][2] = __uint_as_float(u.y << 16); mv[i][3] = __uint_as_float(u.y & 0xffff0000u);
    mv[i][4] = __uint_as_float(u.z << 16); mv[i][5] = __uint_as_float(u.z & 0xffff0000u);
    mv[i][6] = __uint_as_float(u.w << 16); mv[i][7] = __uint_as_float(u.w & 0xffff0000u);
    {
      const uint4 hi = *(const uint4*)(p.xb + (size_t)row * DM + c);
      xv[i][0] = __uint_as_float(hi.x << 16); xv[i][1] = __uint_as_float(hi.x & 0xffff0000u);
      xv[i][2] = __uint_as_float(hi.y << 16); xv[i][3] = __uint_as_float(hi.y & 0xffff0000u);
      xv[i][4] = __uint_as_float(hi.z << 16); xv[i][5] = __uint_as_float(hi.z & 0xffff0000u);
      xv[i][6] = __uint_as_float(hi.w << 16); xv[i][7] = __uint_as_float(hi.w & 0xffff0000u);
    }
#pragma unroll
    for (int j = 0; j < 8; ++j) ss += mv[i][j] * mv[i][j];
  }
  ss = wave_sum(ss);
  const float rs = rsqrtf(ss * (1.f / DM) + 1e-6f);
  float s2 = 0.f;
#pragma unroll
  for (int i = 0; i < 4; ++i) {
    const int c = lane * 8 + 512 * i;
    const f32x4 ga = *(const f32x4*)(gp + c), gb = *(const f32x4*)(gp + c + 4);
    float y[8];
#pragma unroll
    for (int j = 0; j < 4; ++j) { y[j] = xv[i][j] + mv[i][j] * rs * ga[j]; y[4 + j] = xv[i][4 + j] + mv[i][4 + j] * rs * gb[j]; }
    if (l == 3) {
      f32x4 ya = {y[0], y[1], y[2], y[3]}, yb = {y[4], y[5], y[6], y[7]};
      *(f32x4*)(p.out + (size_t)row * DM + c) = ya; *(f32x4*)(p.out + (size_t)row * DM + c + 4) = yb;
    } else {
#pragma unroll
      for (int j = 0; j < 8; ++j) s2 += y[j] * y[j];
      uint4 w; w.x = pk2(y[0], y[1]); w.y = pk2(y[2], y[3]); w.z = pk2(y[4], y[5]); w.w = pk2(y[6], y[7]);
      *(uint4*)(p.xb + (size_t)row * DM + c) = w;
    }
  }
  if (l != 3) {
    s2 = wave_sum(s2);
    if (lane == 0) p.rstd[row] = rsqrtf(s2 * (1.f / DM) + 1e-6f);
  }
}

__global__ void __launch_bounds__(NTHR, 2) mega(Params p) {
  cg::grid_group grid = cg::this_grid();
  __shared__ __attribute__((aligned(16))) char lds[LDS_BYTES];
  const int G = gridDim.x, bid = blockIdx.x, tid = threadIdx.x;
  const char* wsb = (const char*)p.wb_in;
  if (tid == 0) *(uint4*)(lds + XBW_OFF) = make_uint4(0u, 0u, 0u, 0u);
  __syncthreads();
  const XcdBarrier xb = xcd_barrier_post(p.bar, (volatile LAS unsigned*)(lds + XBW_OFF));
  if (p.use_cg) grid.sync();

  for (int it = bid; it < 256 + 4608 + 2048; it += G) {
    if (it < 256) {
      ssm_prep_item(p, it >> 6, it & 63, lds);
    } else if (it < 256 + 4608) {
      const int j = it - 256, l = j / 1152, r = j % 1152;
      if (r < 768) wconv_item(p.w_in + (size_t)l * DM * DIN, DM, DIN, p.wb_in + (size_t)l * DIN * DM, p.pre_g + l * DM, 0, r / 24, r % 24, lds);
      else if (r < 896) { const int r2 = r - 768; wconv_item(p.w_glu + (size_t)l * 1024 * 2048, 1024, 2048, p.wb_glu + (size_t)l * 2048 * 1024, nullptr, 1, r2 / 8, r2 % 8, lds); }
      else { const int r3 = r - 896; wconv_item(p.w_out + (size_t)l * DM * DM, DM, DM, p.wb_out + (size_t)l * DM * DM, nullptr, 0, r3 / 8, r3 % 8, lds); }
    } else {
      const int row = (it - 256 - 4608) * 8 + (ltid() >> 6);
      xprep_row(p.x, row, p.xb, p.rstd);
    }
  }
  xcd_barrier(xb);

#pragma unroll 1
  for (int l = 0; l < 4; ++l) {
    {
      const bf16_t* A = p.xb;
      const bf16_t* Bt = p.wb_in + (size_t)l * DIN * DM;
      for (int rep = 0; rep < REP_P1; ++rep)
      for (int it = bid; it < 64 * 24; it += G) {
        const int mt = it / 24, nt = it % 24;
        const unsigned a0 = (unsigned)((const char*)(A + (size_t)mt * 256 * DM) - wsb);
        const unsigned b0 = (unsigned)((const char*)(Bt + (size_t)nt * 256 * DM) - wsb);
        auto la = [&](int row, int kc, int kt) { return a0 + (unsigned)((row * DM + kt * 64 + kc * 8) * 2); };
        auto lb = [&](int row, int kc, int kt) { return b0 + (unsigned)((row * DM + kt * 64 + kc * 8) * 2); };
        auto epi = [&](f32x4v (&acc)[8][4], int wm, int wn, int l15, int q4) {
          const int seg = nt >> 2;
          const float qs = (seg == 0) ? QSCALE : 1.f;
          const bool act = (seg == 3 || seg == 5);
#pragma unroll
          for (int i = 0; i < 8; ++i) {
            const int m = mt * 256 + wm * 128 + i * 16 + l15;
            const float rs = p.rstd[m] * qs;
            bf16_t* orow = p.proj + (size_t)m * DIN + nt * 256 + wn * 64 + 4 * q4;
            bf16_t* urow = p.mix + ((size_t)((m >> 13) * 64 + (nt - 16) * 16 + wn * 4) * SEQ + (m & (SEQ - 1))) * 16 + 4 * q4;
#pragma unroll
            for (int j = 0; j < 4; ++j) {
              float v0 = acc[i][j][0] * rs, v1 = acc[i][j][1] * rs, v2 = acc[i][j][2] * rs, v3 = acc[i][j][3] * rs;
              if (act) { v0 = silu_f(v0); v1 = silu_f(v1); v2 = silu_f(v2); v3 = silu_f(v3); }
              uint2 o; o.x = pk2(v0, v1); o.y = pk2(v2, v3);
              if (seg == 4) *(uint2*)(urow + (size_t)j * SEQ * 16) = o;
              else *(uint2*)(orow + j * 16) = o;
            }
          }
        };
        gemm_tile16(lds, wsb, DM / 64, la, lb, epi);
      }
    }
    xcd_barrier(xb);
    for (int rep = 0; rep < REP_P3; ++rep)
    for (int it = bid; it < 128 + 512; it += G) {
      if (it < 128) {
        const int g = 8 * (it & 7) + ((it >> 3) & 7), b = it >> 6, bg = b * 64 + g;
        const unsigned a0 = (unsigned)((const char*)(p.Wst + (size_t)(l * 64 + g) * 128 * 1024) - wsb);
        const unsigned u0 = (unsigned)((const char*)(p.mix + (size_t)bg * SEQ * 16) - wsb);
        auto la = [&](int row, int kc, int kt) { return a0 + (unsigned)((row * 1024 + kt * 64 + kc * 8) * 2); };
        auto lb = [&](int row, int kc, int kt) { return u0 + (unsigned)((row * 1024 + kt * 64 + kc * 8) * 2); };
        float* El = (float*)lds;
        auto epi = [&](f32x16 (&acc)[1][2], int wm, int wn, int l31, int h) {
          __syncthreads();
#pragma unroll
          for (int j = 0; j < 2; ++j)
#pragma unroll
              for (int r = 0; r < 16; ++r) {
                const int m = wm * 32 + crow(r, h), n = wn * 64 + j * 32 + l31;
                El[m * 129 + n] = acc[0][j][r];
              }
        };
        gemm_tile<4, 2, 1, false, 4>(lds, wsb, 16, la, lb, epi);
        __syncthreads();
        const int t2 = ltid();
        if (t2 < 64) {
          const int pp = t2;
          const float lr = p.lamL[((l * 64 + g) * 64 + pp) * 2], li = p.lamL[((l * 64 + g) * 64 + pp) * 2 + 1];
          bf16_t* Hb = p.Hb + (size_t)bg * 128 * 128;
          float hr = 0.f, hi = 0.f;
#pragma unroll 4
          for (int c = 0; c < 128; ++c) {
            Hb[c * 128 + pp] = f2bf(hr);
            Hb[c * 128 + 64 + pp] = f2bf(hi);
            const float er = El[pp * 129 + c], ei = El[(pp + 64) * 129 + c];
            const float n2 = lr * hr - li * hi + er;
            hi = lr * hi + li * hr + ei;
            hr = n2;
          }
        }
        __syncthreads();
      } else {
        attn_item(p, wsb, l, it - 128, lds);
      }
    }
    xcd_barrier(xb);
    for (int rep = 0; rep < REP_SSM; ++rep)
    for (int it = bid; it < 512; it += G) {
      const int jj = it & 255, yy = jj >> 3, g = 8 * (jj & 7) + (yy & 7), b = (yy >> 3) & 1, bg = b * 64 + g;
      const int k4 = ((yy >> 4) & 1) + 2 * (it >> 8), mt = (k4 < 2) ? k4 : 5 - k4;
      const int nkT = 4 * (mt + 1);
      const unsigned kc0 = (unsigned)((const char*)(p.Kc + (size_t)(l * 64 + g) * 16 * 64 * 16) - wsb);
      const unsigned wo0 = (unsigned)((const char*)(p.Wo + (size_t)(l * 64 + g) * 1024 * 128) - wsb);
      const unsigned u0 = (unsigned)((const char*)(p.mix + (size_t)bg * SEQ * 16) - wsb);
      const unsigned hb0 = (unsigned)((const char*)(p.Hb + (size_t)bg * 128 * 128) - wsb);
      const unsigned zero = (unsigned)((const char*)p.zero - wsb);
      auto la = [&](int row, int kc, int kt) -> unsigned {
        const int m = mt * 256 + row, t = m >> 4, co = m & 15;
        if (kt < nkT) {
          const int s = kt * 4 + (kc >> 1);
          return (s <= t) ? kc0 + (unsigned)(((co * 64 + (t - s)) * 16 + (kc & 1) * 8) * 2) : zero;
        }
        return wo0 + (unsigned)((m * 128 + (kt - nkT) * 64 + kc * 8) * 2);
      };
      auto lb = [&](int row, int kc, int kt) -> unsigned {
        if (kt < nkT) return u0 + (unsigned)((row * 1024 + kt * 64 + kc * 8) * 2);
        return hb0 + (unsigned)((row * 128 + (kt - nkT) * 64 + kc * 8) * 2);
      };
      auto epi = [&](f32x16 (&acc)[2][2], int wm, int wn, int l31, int h) {
#pragma unroll
        for (int i = 0; i < 2; ++i)
#pragma unroll
          for (int j = 0; j < 2; ++j) {
            const int c = wn * 64 + j * 32 + l31;
#pragma unroll
            for (int g4 = 0; g4 < 4; ++g4) {
              const int m = mt * 256 + wm * 64 + i * 32 + 8 * g4 + 4 * h;
              const int t = m >> 4, co = m & 15;
              const size_t tok = (size_t)b * SEQ + c * 64 + t;
              const int ch = g * 16 + co;
              const uint2 uu = *(const uint2*)(p.mix + ((size_t)bg * SEQ + c * 64 + t) * 16 + co);
              const f32x4 dd = *(const f32x4*)(p.ssm_d + l * 1024 + ch);
              const float y0 = acc[i][j][4 * g4 + 0] + dd[0] * __uint_as_float(uu.x << 16);
              const float y1 = acc[i][j][4 * g4 + 1] + dd[1] * __uint_as_float(uu.x & 0xffff0000u);
              const float y2 = acc[i][j][4 * g4 + 2] + dd[2] * __uint_as_float(uu.y << 16);
              const float y3 = acc[i][j][4 * g4 + 3] + dd[3] * __uint_as_float(uu.y & 0xffff0000u);
              uint2 o; o.x = pk2(gelu_tanh_f(y0), gelu_tanh_f(y1)); o.y = pk2(gelu_tanh_f(y2), gelu_tanh_f(y3));
              *(uint2*)(p.ybuf + tok * 1024 + ch) = o;
            }
          }
      };
      gemm_tile<4, 2, 2, false, 3>(lds, wsb, nkT + 2, la, lb, epi);
    }
    xcd_barrier(xb);
    {
      const bf16_t* Bt = p.wb_glu + (size_t)l * 2048 * 1024;
      for (int rep = 0; rep < REP_P56; ++rep)
      for (int it = bid; it < 64 * 8; it += G) {
        const int xx = it & 7, yy = (it >> 3) & 31, mt = 32 * (it >> 8) + 8 * (xx >> 1) + (yy & 7), nt = 4 * (xx & 1) + (yy >> 3);
        const unsigned a0 = (unsigned)((const char*)(p.ybuf + (size_t)mt * 256 * 1024) - wsb);
        const unsigned b0 = (unsigned)((const char*)(Bt + (size_t)nt * 256 * 1024) - wsb);
        auto la = [&](int row, int kc, int kt) { return a0 + (unsigned)((row * 1024 + kt * 64 + kc * 8) * 2); };
        auto lb = [&](int row, int kc, int kt) { return b0 + (unsigned)((row * 1024 + kt * 64 + kc * 8) * 2); };
        auto epi = [&](f32x4v (&acc)[8][4], int wm, int wn, int l15, int q4) {
          const int jj = (nt * 4 + wn) * 32 + 4 * q4;
#pragma unroll
          for (int i = 0; i < 8; ++i) {
            const size_t m = (size_t)mt * 256 + wm * 128 + i * 16 + l15;
            const bf16_t* zrow = p.proj + m * DIN + 5120 + jj;
            bf16_t* orow = p.mixin + m * DM + 1024 + jj;
#pragma unroll
            for (int j = 0; j < 2; ++j) {
              const uint2 z = *(const uint2*)(zrow + 16 * j);
              const float v0 = acc[i][j][0] * sigmoid_f(acc[i][j + 2][0]) * __uint_as_float(z.x << 16);
              const float v1 = acc[i][j][1] * sigmoid_f(acc[i][j + 2][1]) * __uint_as_float(z.x & 0xffff0000u);
              const float v2 = acc[i][j][2] * sigmoid_f(acc[i][j + 2][2]) * __uint_as_float(z.y << 16);
              const float v3 = acc[i][j][3] * sigmoid_f(acc[i][j + 2][3]) * __uint_as_float(z.y & 0xffff0000u);
              uint2 o; o.x = pk2(v0, v1); o.y = pk2(v2, v3);
              *(uint2*)(orow + 16 * j) = o;
            }
          }
        };
        gemm_tile16(lds, wsb, 16, la, lb, epi);
      }
    }
    xcd_barrier(xb);
    {
      const bf16_t* Bt = p.wb_out + (size_t)l * DM * DM;
      for (int rep = 0; rep < REP_P56; ++rep)
      for (int it = bid; it < 64 * 8; it += G) {
        const int xx = it & 7, yy = (it >> 3) & 31, mt = 32 * (it >> 8) + 8 * (xx >> 1) + (yy & 7), nt = 4 * (xx & 1) + (yy >> 3);
        const unsigned a0 = (unsigned)((const char*)(p.mixin + (size_t)mt * 256 * DM) - wsb);
        const unsigned b0 = (unsigned)((const char*)(Bt + (size_t)nt * 256 * DM) - wsb);
        auto la = [&](int row, int kc, int kt) { return a0 + (unsigned)((row * DM + kt * 64 + kc * 8) * 2); };
        auto lb = [&](int row, int kc, int kt) { return b0 + (unsigned)((row * DM + kt * 64 + kc * 8) * 2); };
        auto epi = [&](f32x4v (&acc)[8][4], int wm, int wn, int l15, int q4) {
#pragma unroll
          for (int i = 0; i < 8; ++i) {
            const size_t m = (size_t)mt * 256 + wm * 128 + i * 16 + l15;
            bf16_t* orow = p.mix + m * DM + nt * 256 + wn * 64 + 4 * q4;
#pragma unroll
            for (int j = 0; j < 4; ++j) {
              uint2 o; o.x = pk2(acc[i][j][0], acc[i][j][1]); o.y = pk2(acc[i][j][2], acc[i][j][3]);
              *(uint2*)(orow + j * 16) = o;
            }
          }
        };
        gemm_tile16(lds, wsb, DM / 64, la, lb, epi);
      }
    }
    xcd_barrier(xb);
    for (int it = bid; it < NTOK / 8; it += G) resid_row(p, l, it * 8 + (ltid() >> 6));
    xcd_barrier(xb);
  }
}

extern "C" void kernel_launch(void* const* d_in, const int* in_sizes, int n_in, void* d_out, int out_size, void* d_ws,
                              size_t ws_size, hipStream_t stream) {
  static int grid_blocks = 0;
  if (!grid_blocks) {
    int dev = 0, cus = 0, per_cu = 0;
    hipGetDevice(&dev);
    hipDeviceGetAttribute(&cus, hipDeviceAttributeMultiprocessorCount, dev);
    hipOccupancyMaxActiveBlocksPerMultiprocessor(&per_cu, mega, NTHR, 0);
    if (per_cu < 1) per_cu = 1;
    if (per_cu > 1) per_cu = 1;
    grid_blocks = cus * per_cu;
  }
  Params p{};
  p.x = (const float*)d_in[0]; p.rel_bias = (const float*)d_in[1]; p.pre_g = (const float*)d_in[2]; p.post_g = (const float*)d_in[3];
  p.w_in = (const float*)d_in[4]; p.lq1 = (const float*)d_in[5]; p.lk1 = (const float*)d_in[6]; p.lq2 = (const float*)d_in[7];
  p.lk2 = (const float*)d_in[8]; p.subln_g = (const float*)d_in[9]; p.a_re = (const float*)d_in[10]; p.a_im = (const float*)d_in[11];
  p.log_dt = (const float*)d_in[12]; p.b_re = (const float*)d_in[13]; p.b_im = (const float*)d_in[14]; p.c_re = (const float*)d_in[15];
  p.c_im = (const float*)d_in[16]; p.ssm_d = (const float*)d_in[17]; p.w_glu = (const float*)d_in[18]; p.w_out = (const float*)d_in[19];
  p.out = (float*)d_out;
  char* ws = (char*)d_ws;
  size_t off = 0;
  auto take = [&](size_t bytes) { char* r = ws + off; off += (bytes + 255) & ~(size_t)255; return r; };
  p.wb_in = (bf16_t*)take((size_t)4 * DIN * DM * 2);
  p.wb_glu = (bf16_t*)take((size_t)4 * 2048 * 1024 * 2);
  p.wb_out = (bf16_t*)take((size_t)4 * DM * DM * 2);
  p.proj = (bf16_t*)take((size_t)NTOK * DIN * 2);
  p.mixin = (bf16_t*)take((size_t)NTOK * DM * 2);
  p.ybuf = (bf16_t*)take((size_t)NTOK * 1024 * 2);
  p.mix = (bf16_t*)take((size_t)NTOK * DM * 2);
  p.xb = (bf16_t*)take((size_t)NTOK * DM * 2);
  p.Kc = (bf16_t*)take((size_t)4 * 64 * 16 * 64 * 16 * 2);
  p.Wst = (bf16_t*)take((size_t)4 * 64 * 128 * 1024 * 2);
  p.Wo = (bf16_t*)take((size_t)4 * 64 * 1024 * 128 * 2);
  p.Hb = (bf16_t*)take((size_t)128 * 128 * 128 * 2);
  p.rstd = (float*)take((size_t)NTOK * 4);
  p.lam = (float*)take(256);
  p.E = nullptr;
  p.xlo = (bf16_t*)take((size_t)NTOK * DM * 2);
  p.lamL = (float*)take((size_t)4 * 64 * 64 * 2 * 4);
  p.zero = (float*)take(256);
  p.bar = (unsigned*)take(XCD_BAR_WORDS * 4);
  p.use_cg = 0ull;
  if (off > ws_size) { fprintf(stderr, "workspace too small: need %zu have %zu\n", off, ws_size); return; }
  (void)hipMemsetAsync(p.bar, 0, XCD_BAR_WORDS * 4, stream);
  void* args[] = {&p};
  hipError_t e = hipLaunchCooperativeKernel((void*)mega, dim3(grid_blocks), dim3(NTHR), args, 0, stream);
  if (e != hipSuccess) fprintf(stderr, "cooperative launch failed: %s (grid %d)\n", hipGetErrorString(e), grid_blocks);
}
```
